# Optimizing an MI355X kernel written in HIP

```python
import functools
import jax, jax.numpy as jnp
from jax import lax
import numpy as np

D_MODEL = 1024
BATCH = 8
SEQ = 2048
DEPTH = 1
DEC_BATCH = 128
DEC_SEQ = 1
PAST_LEN = 8192
PAGE_SIZE = 128

DIL_GROUPS = ((128, 1), (512, 4), (2048, 16))
N_GROUPS = 3
HEADS_PER_GROUP = 4
HEAD_DIM_A = 128
ATT_QKV = N_GROUPS * HEADS_PER_GROUP * HEAD_DIM_A
ATT_OUT = HEADS_PER_GROUP * HEAD_DIM_A
BAND_BLOCK = 128

RET_HEADS = 4
RET_DK = 128
RET_DV = 256
RET_QK = RET_HEADS * RET_DK
RET_V = RET_HEADS * RET_DV
RET_CHUNK = 128
ROPE_BASE = 10000.0

D_FF = 4 * D_MODEL
EPS = 1e-6
NEG_INF = -1e30

COL_SIZES = (ATT_QKV, ATT_QKV, ATT_QKV, RET_QK, RET_QK, RET_V, RET_V, D_MODEL, D_MODEL)
IN_COLS = 3 * ATT_QKV + 2 * RET_QK + 2 * RET_V + 2 * D_MODEL

kernel_name = "dilated_attn_retention_hybrid_step"


def _rmsnorm(x, g):
    xf = x.astype(jnp.float32)
    y = xf * lax.rsqrt(jnp.mean(xf * xf, axis=-1, keepdims=True) + EPS)
    return (y * g.astype(jnp.float32)).astype(x.dtype)


def _rope(x, pos):
    half = x.shape[-1] // 2
    inv = ROPE_BASE ** (-jnp.arange(half, dtype=jnp.float32) / half)
    ang = pos.astype(jnp.float32)[:, None] * inv[None, :]
    cos = jnp.cos(ang)[None, :, None, :]
    sin = jnp.sin(ang)[None, :, None, :]
    x1, x2 = x[..., :half], x[..., half:]
    return jnp.concatenate([x1 * cos - x2 * sin, x1 * sin + x2 * cos], axis=-1)


def _dilated_band(q, k, v, window, dil):
    B, S, H, Dh = q.shape
    n = S // dil
    span = window // dil
    nb = -(-n // BAND_BLOCK)
    n_pad = nb * BAND_BLOCK

    def to_blocks(t):
        t = t.astype(jnp.float32).reshape(B, n, dil, H, Dh).transpose(0, 2, 1, 3, 4)
        t = jnp.pad(t, ((0, 0), (0, 0), (0, n_pad - n), (0, 0), (0, 0)))
        return t.reshape(B, dil, nb, BAND_BLOCK, H, Dh)

    qb, kb, vb = to_blocks(q), to_blocks(k), to_blocks(v)

    def with_prev(t):
        prev = jnp.concatenate([jnp.zeros_like(t[:, :, :1]), t[:, :, :-1]], axis=2)
        return jnp.concatenate([prev, t], axis=3)

    kk, vv = with_prev(kb), with_prev(vb)
    blk = jnp.arange(nb)[:, None, None] * BAND_BLOCK
    qi = blk + jnp.arange(BAND_BLOCK)[None, :, None]
    ki = blk - BAND_BLOCK + jnp.arange(2 * BAND_BLOCK)[None, None, :]
    rel = qi - ki
    mask = (rel >= 0) & (rel <= span) & (ki >= 0)
    s = jnp.einsum('bcnqhd,bcnkhd->bcnhqk', qb, kk) * (Dh ** -0.5)
    s = jnp.where(mask[None, None, :, None], s, NEG_INF)
    lse = jax.nn.logsumexp(s, axis=-1)
    p = jnp.exp(s - lse[..., None])
    o = jnp.einsum('bcnhqk,bcnkhd->bcnqhd', p, vv)
    o = o.reshape(B, dil, n_pad, H, Dh)[:, :, :n].transpose(0, 2, 1, 3, 4).reshape(B, S, H, Dh)
    lse = lse.transpose(0, 1, 2, 4, 3).reshape(B, dil, n_pad, H)[:, :, :n]
    lse = lse.transpose(0, 2, 1, 3).reshape(B, S, H)
    return o, lse


def _dilated_gather(q, kv_new, kv_buf, window, dil):
    L = kv_buf.shape[1]
    T, Dh = q.shape[1], q.shape[-1]
    span = window // dil
    kv_all = jnp.concatenate([kv_buf.astype(jnp.float32), kv_new.astype(jnp.float32)], axis=1)
    pos_q = PAST_LEN + jnp.arange(T)
    key_pos = pos_q[:, None] - dil * jnp.arange(span + 1)[None, :]
    idx = key_pos - (PAST_LEN - L)
    valid = idx >= 0
    g = jnp.take(kv_all, jnp.maximum(idx, 0), axis=1)
    s = jnp.einsum('bthd,btjhd->bthj', q.astype(jnp.float32), g[:, :, :, 0]) * (Dh ** -0.5)
    s = jnp.where(valid[None, :, None, :], s, NEG_INF)
    lse = jax.nn.logsumexp(s, axis=-1)
    p = jnp.exp(s - lse[..., None])
    o = jnp.einsum('bthj,btjhd->bthd', p, g[:, :, :, 1])
    return o, lse


def _combine_groups(outs, lses):
    w = jax.nn.softmax(jnp.stack(lses, axis=0), axis=0)
    return jnp.sum(w[..., None] * jnp.stack(outs, axis=0), axis=0)


def _attend_prompt(qa, ka, va):
    T = qa.shape[1]
    outs, lses, rows = [], [], []
    for g, (win, dil) in enumerate(DIL_GROUPS):
        o, lse = _dilated_band(qa[:, :, g], ka[:, :, g], va[:, :, g], win, dil)
        outs.append(o)
        lses.append(lse)
        kv = jnp.stack([ka[:, :, g], va[:, :, g]], axis=2)
        rows.append(kv[:, T - min(win, T):])
    return _combine_groups(outs, lses), rows


def _attend_sample(qa, ka, va, caches):
    outs, lses, rows = [], [], []
    for g, (win, dil) in enumerate(DIL_GROUPS):
        kv_new = jnp.stack([ka[:, :, g], va[:, :, g]], axis=2)
        o, lse = _dilated_gather(qa[:, :, g], kv_new, caches[g], win, dil)
        outs.append(o)
        lses.append(lse)
        rows.append(kv_new)
    return _combine_groups(outs, lses), rows


def _ret_chunk(S, qkv, log_g):
    q, k, v = qkv
    C = q.shape[1]
    t = jnp.arange(C, dtype=jnp.float32)
    rel = t[:, None] - t[None, :]
    D = jnp.where(rel[None] >= 0, jnp.exp(log_g[:, None, None] * jnp.maximum(rel, 0.0)[None]), 0.0)
    s = jnp.einsum('bqhd,bkhd->bhqk', q, k) * D[None]
    o = jnp.einsum('bhqk,bkhv->bqhv', s, v)
    inner = jnp.exp(log_g[None, :] * (t[:, None] + 1.0))
    o = o + jnp.einsum('bqhd,bhdv->bqhv', q * inner[None, :, :, None], S)
    tail = jnp.exp(log_g[None, :] * (C - 1.0 - t[:, None]))
    S_new = jnp.exp(log_g * C)[None, :, None, None] * S + jnp.einsum('bkhd,bkhv->bhdv', k * tail[None, :, :, None], v)
    return S_new, o


def _retention(q, k, v, S0):
    B, T, H, dk = q.shape
    dv = v.shape[-1]
    C = RET_CHUNK if T % RET_CHUNK == 0 else T
    n = T // C
    log_g = jnp.log1p(-jnp.power(2.0, -5.0 - jnp.arange(H, dtype=jnp.float32)))

    def chunks(t):
        return t.reshape(B, n, C, H, t.shape[-1]).transpose(1, 0, 2, 3, 4)

    S_fin, o = lax.scan(functools.partial(_ret_chunk, log_g=log_g), S0.astype(jnp.float32),
                        (chunks(q), chunks(k), chunks(v)))
    o = o.transpose(1, 0, 2, 3, 4).reshape(B, T, H, dv)
    return o, S_fin


def _layer(x, pos, attend, S0, lw):
    (w_in, w_att_br, w_ret_br, w_out, w_up, w_down,
     g_ret_norm, g_pre_mix, g_post_mix, g_pre_mlp, g_post_mlp) = lw
    B, T, _ = x.shape
    h = _rmsnorm(x, g_pre_mix)
    z = h @ w_in
    splits, acc = [], 0
    for c in COL_SIZES[:-1]:
        acc += c
        splits.append(acc)
    qa, ka, va, qr, kr, vr, gr, gate_a, gate_r = jnp.split(z, splits, axis=-1)
    shp_a = (B, T, N_GROUPS, HEADS_PER_GROUP, HEAD_DIM_A)
    att, kv_rows = attend(qa.reshape(shp_a), ka.reshape(shp_a), va.reshape(shp_a))
    a = att.reshape(B, T, ATT_OUT).astype(x.dtype) @ w_att_br
    qr = _rope(qr.reshape(B, T, RET_HEADS, RET_DK).astype(jnp.float32), pos)
    kr = _rope(kr.reshape(B, T, RET_HEADS, RET_DK).astype(jnp.float32), pos) * (RET_DK ** -0.5)
    vr = vr.reshape(B, T, RET_HEADS, RET_DV).astype(jnp.float32)
    ro, S_new = _retention(qr, kr, vr, S0)
    mu = jnp.mean(ro, axis=-1, keepdims=True)
    var = jnp.mean(jnp.square(ro - mu), axis=-1, keepdims=True)
    rn = ((ro - mu) * lax.rsqrt(var + EPS)).reshape(B, T, RET_V) * g_ret_norm.astype(jnp.float32)
    r = (jax.nn.silu(gr) * rn.astype(x.dtype)) @ w_ret_br
    m = jax.nn.sigmoid(gate_a) * a + jax.nn.sigmoid(gate_r) * r
    x = x + _rmsnorm(m @ w_out, g_post_mix)
    u = jnp.square(jax.nn.relu(_rmsnorm(x, g_pre_mlp) @ w_up))
    x = x + _rmsnorm(u @ w_down, g_post_mlp)
    return x, kv_rows, S_new


def setup_inputs(seed: int = 0) -> dict:
    key = jax.random.key(seed)
    ks = jax.random.split(key, 20)
    f32 = jnp.float32
    nrm = lambda k, shp, sc: jax.random.normal(k, shp, f32) * sc
    L1, L2, L3 = (min(w, PAST_LEN) for w, _ in DIL_GROUPS)
    kv_shape = lambda L: (DEPTH, DEC_BATCH, L, 2, HEADS_PER_GROUP, HEAD_DIM_A)
    return {
        "x_prompt": nrm(ks[0], (BATCH, SEQ, D_MODEL), 1.0),
        "x_sample": nrm(ks[1], (DEC_BATCH, DEC_SEQ, D_MODEL), 1.0),
        "cache_kv_d1": nrm(ks[2], kv_shape(L1), 1.0),
        "cache_kv_d4": nrm(ks[3], kv_shape(L2), 1.0),
        "cache_kv_d16": nrm(ks[4], kv_shape(L3), 1.0),
        "state_ret": nrm(ks[5], (DEPTH, DEC_BATCH, RET_HEADS, RET_DK, RET_DV), 1.0),
        "w_in": nrm(ks[6], (DEPTH, D_MODEL, IN_COLS), D_MODEL ** -0.5),
        "w_att_br": nrm(ks[7], (DEPTH, ATT_OUT, D_MODEL), ATT_OUT ** -0.5),
        "w_ret_br": nrm(ks[8], (DEPTH, RET_V, D_MODEL), RET_V ** -0.5),
        "w_out": nrm(ks[9], (DEPTH, D_MODEL, D_MODEL), D_MODEL ** -0.5),
        "w_up": nrm(ks[10], (DEPTH, D_MODEL, D_FF), D_MODEL ** -0.5),
        "w_down": nrm(ks[11], (DEPTH, D_FF, D_MODEL), D_FF ** -0.5),
        "g_ret_norm": 1.0 + nrm(ks[12], (DEPTH, RET_V), 0.05),
        "g_pre_mix": 1.0 + nrm(ks[13], (DEPTH, D_MODEL), 0.05),
        "g_post_mix": 1.0 + nrm(ks[14], (DEPTH, D_MODEL), 0.05),
        "g_pre_mlp": 1.0 + nrm(ks[15], (DEPTH, D_MODEL), 0.05),
        "g_post_mlp": 1.0 + nrm(ks[16], (DEPTH, D_MODEL), 0.05),
    }


def reference(x_prompt, x_sample, cache_kv_d1, cache_kv_d4, cache_kv_d16, state_ret,
              w_in, w_att_br, w_ret_br, w_out, w_up, w_down,
              g_ret_norm, g_pre_mix, g_post_mix, g_pre_mlp, g_post_mlp):
    xp, xs = x_prompt, x_sample
    pos_p = jnp.arange(SEQ, dtype=jnp.int32)
    pos_s = PAST_LEN + jnp.arange(DEC_SEQ, dtype=jnp.int32)
    p_rows = [[], [], []]
    s_rows = [[], [], []]
    p_states, s_states = [], []
    for l in range(DEPTH):
        lw = (w_in[l], w_att_br[l], w_ret_br[l], w_out[l], w_up[l], w_down[l],
              g_ret_norm[l], g_pre_mix[l], g_post_mix[l], g_pre_mlp[l], g_post_mlp[l])
        S0 = jnp.zeros((BATCH, RET_HEADS, RET_DK, RET_DV), jnp.float32)
        xp, rows_p, Sp = _layer(xp, pos_p, _attend_prompt, S0, lw)
        attend_s = functools.partial(_attend_sample, caches=(cache_kv_d1[l], cache_kv_d4[l], cache_kv_d16[l]))
        xs, rows_s, Ss = _layer(xs, pos_s, attend_s, state_ret[l], lw)
        for g in range(N_GROUPS):
            p_rows[g].append(rows_p[g])
            s_rows[g].append(rows_s[g])
        p_states.append(Sp)
        s_states.append(Ss)
    kv_d1_p = jnp.stack(p_rows[0], axis=0)
    kv_d4_p = jnp.stack(p_rows[1], axis=0)
    kv_d16_p = jnp.stack(p_rows[2], axis=0)
    ret_p = jnp.stack(p_states, axis=0)
    kv_d1_s = jnp.stack(s_rows[0], axis=0)
    kv_d4_s = jnp.stack(s_rows[1], axis=0)
    kv_d16_s = jnp.stack(s_rows[2], axis=0)
    ret_s = jnp.stack(s_states, axis=0)
    return (xp, xs, kv_d1_p, kv_d4_p, kv_d16_p, ret_p, kv_d1_s, kv_d4_s, kv_d16_s, ret_s)
```

```cpp
#include <hip/hip_runtime.h>
#include <cstdio>
#include <cstdint>

namespace pg8 {
#define PG8_LAS __attribute__((address_space(3)))
typedef unsigned short bf16_t;
typedef short bf16x8 __attribute__((ext_vector_type(8)));
typedef float f32x4 __attribute__((ext_vector_type(4)));
typedef unsigned u32x4 __attribute__((ext_vector_type(4)));
typedef unsigned u32x2 __attribute__((ext_vector_type(2)));
constexpr int BM = 256, BK = 64, HALF = 128, HTB = HALF * BK * 2, STAGE_BYTES = 8 * HTB, NXCD = 8, WGM = 8;

__host__ __device__ __forceinline__ int lds_byte(int r, int c) { const int st = (r >> 4) * 2 + (c >> 5), rr = r & 15, cc = c & 31, ob = rr * 64 + cc * 2; return st * 1024 + (ob ^ (((ob >> 9) & 1) << 5)); }
__host__ __device__ __forceinline__ void stage_rc(int b, int& R, int& C) { const int st = b / 1024, sb = b % 1024, swz = sb ^ (((sb >> 9) & 1) << 5); R = (st >> 1) * 16 + swz / 64; C = (st & 1) * 32 + (swz % 64) / 2; }
__host__ __device__ __forceinline__ int perm32(int rho) { const int n = rho >> 4, i = rho & 15; return 8 * (i >> 2) + 4 * n + (i & 3); }

struct Unit { int pm, pn; };
struct Gemm { const bf16_t* A; const bf16_t* Bt; int M, N, K, lda, ldb; };

struct StaticOrder {
    int nM, nN, nwg, G, c;
    __host__ __device__ void init(int M, int N, int G_, int c_) { nM = M / BM; nN = N / BM; nwg = nM * nN; G = G_; c = c_; }
    __host__ __device__ bool next(int i, Unit& u) const {
        const long L = (long)i * G + c; if (L >= nwg) return false;
        int wgid = (int)L; { const int q = nwg / NXCD, r = nwg % NXCD, xcd = wgid % NXCD, off = wgid / NXCD; wgid = (xcd < r ? xcd * (q + 1) : r * (q + 1) + (xcd - r) * q) + off; }
        const int nig = WGM * nN, gid = wgid / nig, fm = gid * WGM, gsz = (nM - fm) < WGM ? (nM - fm) : WGM;
        u.pm = fm + ((wgid % nig) % gsz); u.pn = (wgid % nig) / gsz; return true;
    }
};

__device__ __forceinline__ unsigned cvt_pk_bf16(float lo, float hi) { unsigned r; asm volatile("v_cvt_pk_bf16_f32 %0, %1, %2" : "=v"(r) : "v"(lo), "v"(hi)); return r; }
__device__ __forceinline__ float bf_lo(unsigned w) { return __uint_as_float(w << 16); }
__device__ __forceinline__ float bf_hi(unsigned w) { return __uint_as_float(w & 0xffff0000u); }
__device__ __forceinline__ float sigmoidf_(float x) { return 1.0f / (1.0f + __expf(-x)); }


template <bool ALIGN_EPI, class Epi>
__device__ __forceinline__ void gemm_phase(PG8_LAS unsigned char* lds, const Gemm g, const StaticOrder& S, const Epi& E) {
    const int tid = threadIdx.x, wid = __builtin_amdgcn_readfirstlane(tid >> 6), lane = tid & 63, wr = wid >> 2, wc = wid & 3, fr = lane & 15, fq = lane >> 4;
    const int K = g.K, nt = K / BK;
    unsigned voffA[2], voffB[2];
#pragma unroll
    for (int i = 0; i < 2; ++i) { int R, C; stage_rc(tid * 16 + i * 8192, R, C); const int Rb = Epi::PERM ? ((R & ~31) + perm32(R & 31)) : R;
        voffA[i] = (unsigned)(R * g.lda + C) * 2u; voffB[i] = (unsigned)(Rb * g.ldb + C) * 2u; }
    const size_t kstep = (size_t)(BK * 2);
    const size_t hstepA = (size_t)HALF * g.lda * 2, hstepB = (size_t)HALF * g.ldb * 2;
    const size_t tstepA = 2 * hstepA, tstepB = 2 * hstepB;
    const unsigned ldsw = (unsigned)wid * 1024u;
    const int aoff = lds_byte(wr * 64 + fr, fq * 8), boff = lds_byte(wc * 32 + fr, fq * 8);
#define PG8_SA(b, h) (((b) * 2 + (h)) * HTB)
#define PG8_SB(b, h) ((4 + (b) * 2 + (h)) * HTB)
#define PG8_STAGE(bufoff, gbase, voff) do { _Pragma("unroll") for (int _i = 0; _i < 2; ++_i) \
        __builtin_amdgcn_global_load_lds((const unsigned*)((const char*)(gbase) + (voff)[_i]), (PG8_LAS unsigned*)(lds + (bufoff) + ldsw + _i * 8192), 16, 0, 0); } while (0)
#define PG8_LDA(dst, b, h) do { _Pragma("unroll") for (int m = 0; m < 4; ++m) _Pragma("unroll") for (int k = 0; k < 2; ++k) dst[m][k] = *(const PG8_LAS bf16x8*)(lds + PG8_SA(b, h) + aoff + m * 2048 + k * 1024); } while (0)
#define PG8_LDB(dst, b, h) do { _Pragma("unroll") for (int n = 0; n < 2; ++n) _Pragma("unroll") for (int k = 0; k < 2; ++k) dst[n][k] = *(const PG8_LAS bf16x8*)(lds + PG8_SB(b, h) + boff + n * 2048 + k * 1024); } while (0)
#define PG8_MMA(ai, bj, At, Bt) do { __builtin_amdgcn_s_setprio(1); _Pragma("unroll") for (int m = 0; m < 4; ++m) _Pragma("unroll") for (int n = 0; n < 2; ++n) _Pragma("unroll") for (int k = 0; k < 2; ++k) \
        acc[ai][bj][m][n] = __builtin_amdgcn_mfma_f32_16x16x32_bf16(Bt[n][k], At[m][k], acc[ai][bj][m][n], 0, 0, 0); __builtin_amdgcn_s_setprio(0); } while (0)
#define PG8_WAIT_V(n) asm volatile("s_waitcnt vmcnt(" #n ")" ::: "memory")
#define PG8_WAIT_L(n) asm volatile("s_waitcnt lgkmcnt(" #n ")" ::: "memory")
#define PG8_BAR __builtin_amdgcn_s_barrier()
#define PG8_SCHED __builtin_amdgcn_sched_barrier(0)
    Unit cur, nxt; int ui = 0;
    if (!S.next(0, cur)) return;
    f32x4 acc[2][2][4][2];
#pragma unroll
    for (int a = 0; a < 2; ++a)
#pragma unroll
        for (int b = 0; b < 2; ++b)
#pragma unroll
            for (int m = 0; m < 4; ++m)
#pragma unroll
                for (int n = 0; n < 2; ++n) acc[a][b][m][n] = (f32x4){0.f, 0.f, 0.f, 0.f};
    bf16x8 At[4][2], B0[2][2], B1[2][2];
    const char* cA = (const char*)g.A + (size_t)cur.pm * tstepA; const char* cB = (const char*)g.Bt + (size_t)cur.pn * tstepB;
    PG8_STAGE(PG8_SB(0, 0), cB, voffB); PG8_STAGE(PG8_SB(0, 1), cB + hstepB, voffB); PG8_STAGE(PG8_SA(0, 0), cA, voffA); PG8_STAGE(PG8_SA(0, 1), cA + hstepA, voffA);
    if (wr == 1) PG8_BAR;
    PG8_WAIT_V(2); PG8_BAR;
    PG8_STAGE(PG8_SB(1, 0), cB + kstep, voffB); PG8_STAGE(PG8_SA(1, 0), cA + kstep, voffA); PG8_STAGE(PG8_SB(1, 1), cB + hstepB + kstep, voffB);
    PG8_WAIT_V(6); PG8_BAR;
    for (;;) {
        const bool has_next = S.next(ui + 1, nxt);
        const char* nA = has_next ? (const char*)g.A + (size_t)nxt.pm * tstepA : cA; const char* nB = has_next ? (const char*)g.Bt + (size_t)nxt.pn * tstepB : cB;
        for (int t = 0; t < nt; t += 2) {
            const bool last = (t == nt - 2);
            const char* a1 = cA + (size_t)(t + 1) * kstep;
            const char* a2 = last ? nA : cA + (size_t)(t + 2) * kstep; const char* b2 = last ? nB : cB + (size_t)(t + 2) * kstep;
            const char* a3 = a2 + kstep; const char* b3 = b2 + kstep;
            PG8_LDB(B0, 0, 0); PG8_LDB(B1, 0, 1); PG8_SCHED; PG8_LDA(At, 0, 0); PG8_STAGE(PG8_SA(1, 1), a1 + hstepA, voffA);
            PG8_WAIT_V(8); PG8_WAIT_L(0); PG8_BAR; PG8_MMA(0, 0, At, B0); PG8_MMA(0, 1, At, B1); PG8_BAR; PG8_SCHED;
            PG8_LDA(At, 0, 1); PG8_STAGE(PG8_SB(0, 0), b2, voffB); PG8_STAGE(PG8_SB(0, 1), b2 + hstepB, voffB); PG8_STAGE(PG8_SA(0, 0), a2, voffA);
            PG8_WAIT_V(8); PG8_WAIT_L(0); PG8_BAR; PG8_MMA(1, 0, At, B0); PG8_MMA(1, 1, At, B1); PG8_BAR; PG8_SCHED;
            PG8_LDB(B0, 1, 0); PG8_LDB(B1, 1, 1); PG8_SCHED; PG8_LDA(At, 1, 0); PG8_STAGE(PG8_SA(0, 1), a2 + hstepA, voffA);
            PG8_WAIT_V(8); PG8_WAIT_L(0); PG8_BAR; PG8_MMA(0, 0, At, B0); PG8_MMA(0, 1, At, B1); PG8_BAR; PG8_SCHED;
            PG8_LDA(At, 1, 1); PG8_STAGE(PG8_SB(1, 0), b3, voffB); PG8_STAGE(PG8_SB(1, 1), b3 + hstepB, voffB); PG8_STAGE(PG8_SA(1, 0), a3, voffA);
            PG8_WAIT_V(8); PG8_WAIT_L(0); PG8_BAR; PG8_MMA(1, 0, At, B0); PG8_MMA(1, 1, At, B1); PG8_BAR; PG8_SCHED;
        }
        if constexpr (ALIGN_EPI) { if (wr == 0) PG8_BAR; }
        E(acc, cur, wr, wc, fr, fq);
        if (!has_next) break;
#pragma unroll
        for (int a = 0; a < 2; ++a)
#pragma unroll
            for (int b = 0; b < 2; ++b)
#pragma unroll
                for (int m = 0; m < 4; ++m)
#pragma unroll
                    for (int n = 0; n < 2; ++n) acc[a][b][m][n] = (f32x4){0.f, 0.f, 0.f, 0.f};
        cur = nxt; cA = nA; cB = nB; ++ui;
        if constexpr (ALIGN_EPI) { if (wr == 1) PG8_BAR; }
    }
    PG8_WAIT_V(0);
    if constexpr (!ALIGN_EPI) { if (wr == 0) PG8_BAR; }
    PG8_BAR;
#undef PG8_SA
#undef PG8_SB
#undef PG8_STAGE
#undef PG8_LDA
#undef PG8_LDB
#undef PG8_MMA
#undef PG8_WAIT_V
#undef PG8_WAIT_L
#undef PG8_BAR
#undef PG8_SCHED
}
}

constexpr int NWAVES = 8;
constexpr int DM = 1024, SEQ = 2048, NB = 8, MP = NB * SEQ  , MS = 128, MREAL = MP + MS  , MPAD = 16640  ;
constexpr int NIN = 9728, FF = 4096, KBR = 1536;
constexpr int C_QA = 0, C_KA = 1536, C_VA = 3072, C_QR = 4608, C_KR = 5120, C_VR = 5632, C_GR = 6656, C_GA = 7680, C_GRT = 8704;
constexpr float EPS = 1e-6f;
constexpr size_t O_Y = 0, O_KV1P = 16908288, O_KV4P = O_KV1P + 1048576, O_KV16P = O_KV4P + 4194304, O_STP = O_KV16P + 16777216,
                 O_KV1S = O_STP + 1048576, O_KV4S = O_KV1S + 131072, O_KV16S = O_KV4S + 131072, O_STS = O_KV16S + 131072, O_END = O_STS + 16777216;
static_assert(O_END == 57147392, "d_out map");

constexpr size_t MiB = 1u << 20;
constexpr size_t WS_CTL = 0, CTL_ZERO_BYTES = 64 * 1024;
constexpr size_t WS_WIN = 2 * MiB;
constexpr size_t WS_WBR = 22 * MiB;
constexpr size_t WS_WOUT = 26 * MiB;
constexpr size_t WS_WUP = 28 * MiB;
constexpr size_t WS_WDN = 36 * MiB;
constexpr size_t WS_ROPE = 44 * MiB;
constexpr size_t WS_XN = 46 * MiB;
constexpr size_t WS_Z = 80 * MiB;
constexpr size_t WS_ABR = 390 * MiB;
constexpr size_t WS_RO = 440 * MiB;
constexpr size_t WS_T1 = 506 * MiB;
constexpr size_t WS_MB = 572 * MiB;
constexpr size_t WS_O = 606 * MiB;
constexpr size_t WS_XN2 = 672 * MiB;
constexpr size_t WS_U = 706 * MiB;
constexpr size_t WS_DN = 838 * MiB;
constexpr size_t WS_END = 904 * MiB;
constexpr int CW_BAR = 1024;

constexpr int RING_BYTES = 131072, LDSCTL_OFF = RING_BYTES, MISC_OFF = LDSCTL_OFF + 320, LDS_BYTES = 147456;

#define GAS __attribute__((address_space(1)))
#define LAS __attribute__((address_space(3)))
typedef unsigned short bf16;
typedef unsigned v4u __attribute__((ext_vector_type(4)));
typedef unsigned v2u __attribute__((ext_vector_type(2)));
typedef float f32x4 __attribute__((ext_vector_type(4)));
typedef float f32x2 __attribute__((ext_vector_type(2)));
#define LDS_WAIT() asm volatile("s_waitcnt lgkmcnt(0)" ::: "memory")
__device__ __forceinline__ unsigned f2bf(float f) { unsigned u = __builtin_bit_cast(unsigned, f); return (u + 0x7fffu + ((u >> 16) & 1u)) >> 16; }
__device__ __forceinline__ unsigned pk2(float lo, float hi) { return f2bf(lo) | (f2bf(hi) << 16); }
__device__ __forceinline__ float bf2f(unsigned short b) { return __uint_as_float((unsigned)b << 16); }

#define XB_TMO      128
#define XB_XCNT(j)  (256  + 64 * (j))
#define XB_XSUB(j)  (1280 + 64 * (j))
#define XB_XGEN(j)  (2304 + 64 * (j))
#define XB_TOP      3328
#define XB_TOPGEN   3392
#define XCD_BAR_WORDS 3456
#define XB_SPIN_CAP (1u << 18)
__device__ __forceinline__ unsigned xb_ld(unsigned* p)              { return __hip_atomic_load(p, __ATOMIC_RELAXED, __HIP_MEMORY_SCOPE_AGENT); }
__device__ __forceinline__ unsigned xb_add(unsigned* p, unsigned v) { return __hip_atomic_fetch_add(p, v, __ATOMIC_RELAXED, __HIP_MEMORY_SCOPE_AGENT); }
__device__ __forceinline__ unsigned xb_xcc_id() { return (unsigned)__builtin_amdgcn_s_getreg((3 << 11) | 20) & 0xFu; }
#define XB_SPIN(cond, bar) do { unsigned _sp = 0; while (cond) { __builtin_amdgcn_s_sleep(1); \
    if ((++_sp & 255u) == 0u) { if (xb_ld(&(bar)[XB_TMO])) break; if (_sp > XB_SPIN_CAP) { atomicAdd(&(bar)[XB_TMO], 1u); break; } } } } while (0)
struct XcdBarrier { unsigned* bar; unsigned x; volatile LAS unsigned* st; };
__device__ __forceinline__ XcdBarrier xcd_barrier_post(unsigned* bar, volatile LAS unsigned* st) {
    XcdBarrier b; b.bar = bar; b.x = xb_xcc_id(); b.st = st;
    if (threadIdx.x == 0) (void)xb_add(&bar[XB_XCNT(b.x)], 1u);
    return b;
}
__device__ __forceinline__ void xcd_barrier_complete(unsigned* bar, unsigned x, unsigned& nloc, unsigned& nx) {
    const unsigned G = gridDim.x * gridDim.y * gridDim.z;
    unsigned sum, cnt, mine, sp = 0u;
    for (;;) {
        sum = 0u; cnt = 0u; mine = 0u;
#pragma unroll
        for (unsigned j = 0; j < 16; ++j) { const unsigned c = xb_ld(&bar[XB_XCNT(j)]); sum += c; cnt += (c > 0u) ? 1u : 0u; mine = (j == x) ? c : mine; }
        if (sum == G) break;
        __builtin_amdgcn_s_sleep(1);
        if ((++sp & 255u) == 0u) { if (xb_ld(&bar[XB_TMO])) break; if (sp > XB_SPIN_CAP) { atomicAdd(&bar[XB_TMO], 1u); break; } }
    }
    nloc = mine > 0u ? mine : 1u; nx = cnt > 0u ? cnt : 1u;
}
__device__ __forceinline__ void xcd_barrier(const XcdBarrier& b) {
    asm volatile("s_waitcnt vmcnt(0)" ::: "memory");
    __syncthreads();
    if (threadIdx.x == 0) {
        unsigned* bar = b.bar;
        __builtin_amdgcn_s_waitcnt(0);
        unsigned nloc = b.st[0], nx = b.st[1];
        if (nloc == 0u) { xcd_barrier_complete(bar, b.x, nloc, nx); b.st[0] = nloc; b.st[1] = nx; }
        const unsigned old = xb_add(&bar[XB_XSUB(b.x)], 1u);
        const unsigned gen = old / nloc;
        if (old + 1u == (gen + 1u) * nloc) {
            __builtin_amdgcn_fence(__ATOMIC_RELEASE, "agent");
            asm volatile("s_waitcnt vmcnt(0)" ::: "memory");
            const unsigned og = xb_add(&bar[XB_TOP], 1u);
            const unsigned tg = og / nx;
            if (og + 1u == (tg + 1u) * nx) xb_add(&bar[XB_TOPGEN], 1u);
            else XB_SPIN(xb_ld(&bar[XB_TOPGEN]) == tg, bar);
            __builtin_amdgcn_fence(__ATOMIC_ACQUIRE, "agent");
            xb_add(&bar[XB_XGEN(b.x)], 1u);
            asm volatile("s_waitcnt vmcnt(0)" ::: "memory");
        } else {
            XB_SPIN(xb_ld(&bar[XB_XGEN(b.x)]) == gen, bar);
            __builtin_amdgcn_fence(__ATOMIC_ACQUIRE, "agent");
            asm volatile("s_waitcnt vmcnt(0)" ::: "memory");
        }
    }
    __syncthreads();
}

struct Frame {
    LAS unsigned char* lds;
    int tid, lane, wave, G, vcu;
    const float *xp, *xs, *c1, *c4, *c16, *st0, *w_in, *w_att, *w_ret, *w_out, *w_up, *w_dn, *g_ret, *g_pre_mix, *g_post_mix, *g_pre_mlp, *g_post_mlp;
    float* out;
    bf16 *WIN, *WBR, *WOUT, *WUP, *WDN, *XN, *Z, *ABR, *MB, *XN2, *U;
    float *ROPE, *RO, *T1, *O, *DN;
};
__device__ __forceinline__ const float* xrow_ptr(const Frame& F, int r) { return r < MP ? F.xp + (size_t)r * DM : F.xs + (size_t)(r - MP) * DM; }
__device__ __forceinline__ float wave_sum(float v) {
#pragma unroll
    for (int o = 1; o < 64; o <<= 1) v += __shfl_xor(v, o);
    return v;
}
__device__ __forceinline__ float wave_max(float v) {
#pragma unroll
    for (int o = 1; o < 64; o <<= 1) v = fmaxf(v, __shfl_xor(v, o));
    return v;
}

struct EpiZ {
    static constexpr bool PERM = true;
    bf16* Z; float* out;
    __device__ __forceinline__ void operator()(const pg8::f32x4 (&acc)[2][2][4][2], const pg8::Unit& u, int wr, int wc, int fr, int fq) const {
        const int row0 = u.pm * 256 + wr * 64 + fr, colt = u.pn * 256, cw = wc * 32 + 8 * fq;
        const bool iskv = (colt >= C_KA && colt < C_QR);
        int kv = 0, g = 0, cc0 = 0;
        if (iskv) { const int c = colt - C_KA; kv = c / 1536; g = (c % 1536) / 512; cc0 = (c % 512) + cw; }
        const int L = g == 0 ? 128 : (g == 1 ? 512 : 2048);
        const size_t offp = g == 0 ? O_KV1P : (g == 1 ? O_KV4P : O_KV16P), offs = g == 0 ? O_KV1S : (g == 1 ? O_KV4S : O_KV16S);
#pragma unroll
        for (int ai = 0; ai < 2; ++ai)
#pragma unroll
            for (int m = 0; m < 4; ++m) {
                const int row = row0 + ai * 128 + m * 16;
                bf16* zp = Z + (size_t)row * NIN + colt + cw;
                float* kp = nullptr;
                if (iskv) {
                    if (row < MP) { const int b = row >> 11, t = row & 2047; if (t >= SEQ - L) kp = out + offp + ((size_t)(b * L + (t - (SEQ - L)))) * 1024 + kv * 512 + cc0; }
                    else if (row < MREAL) kp = out + offs + (size_t)(row - MP) * 1024 + kv * 512 + cc0;
                }
#pragma unroll
                for (int bj = 0; bj < 2; ++bj) {
                    const pg8::f32x4 v0 = acc[ai][bj][m][0], v1 = acc[ai][bj][m][1];
                    pg8::u32x4 w; w.x = pg8::cvt_pk_bf16(v0[0], v0[1]); w.y = pg8::cvt_pk_bf16(v0[2], v0[3]); w.z = pg8::cvt_pk_bf16(v1[0], v1[1]); w.w = pg8::cvt_pk_bf16(v1[2], v1[3]);
                    *(pg8::u32x4*)(zp + bj * 128) = w;
                    if (kp) { *(pg8::f32x4*)(kp + bj * 128) = v0; *(pg8::f32x4*)(kp + bj * 128 + 4) = v1; }
                }
            }
    }
};
struct EpiGateA {
    static constexpr bool PERM = false;
    const bf16* Z; float* T1;
    __device__ __forceinline__ void operator()(const pg8::f32x4 (&acc)[2][2][4][2], const pg8::Unit& u, int wr, int wc, int fr, int fq) const {
        const int row0 = u.pm * 256 + wr * 64 + fr, col0 = u.pn * 256 + wc * 32 + 4 * fq;
#pragma unroll
        for (int ai = 0; ai < 2; ++ai)
#pragma unroll
            for (int m = 0; m < 4; ++m) { const int row = row0 + ai * 128 + m * 16;
#pragma unroll
                for (int bj = 0; bj < 2; ++bj)
#pragma unroll
                    for (int n = 0; n < 2; ++n) { const int col = col0 + bj * 128 + n * 16;
                        const pg8::u32x2 gw = *(const pg8::u32x2*)(Z + (size_t)row * NIN + C_GA + col);
                        const pg8::f32x4 a = acc[ai][bj][m][n]; pg8::f32x4 o;
                        o[0] = pg8::sigmoidf_(pg8::bf_lo(gw.x)) * a[0]; o[1] = pg8::sigmoidf_(pg8::bf_hi(gw.x)) * a[1];
                        o[2] = pg8::sigmoidf_(pg8::bf_lo(gw.y)) * a[2]; o[3] = pg8::sigmoidf_(pg8::bf_hi(gw.y)) * a[3];
                        *(pg8::f32x4*)(T1 + (size_t)row * DM + col) = o; } }
    }
};
struct EpiGateR {
    static constexpr bool PERM = true;
    const bf16* Z; const float* T1; bf16* MB;
    __device__ __forceinline__ void operator()(const pg8::f32x4 (&acc)[2][2][4][2], const pg8::Unit& u, int wr, int wc, int fr, int fq) const {
        const int row0 = u.pm * 256 + wr * 64 + fr, col0 = u.pn * 256 + wc * 32 + 8 * fq;
#pragma unroll
        for (int ai = 0; ai < 2; ++ai)
#pragma unroll
            for (int m = 0; m < 4; ++m) { const int row = row0 + ai * 128 + m * 16;
#pragma unroll
                for (int bj = 0; bj < 2; ++bj) { const int col = col0 + bj * 128;
                    const pg8::u32x4 gw = *(const pg8::u32x4*)(Z + (size_t)row * NIN + C_GRT + col);
                    const pg8::f32x4 t0 = *(const pg8::f32x4*)(T1 + (size_t)row * DM + col), t1 = *(const pg8::f32x4*)(T1 + (size_t)row * DM + col + 4);
                    const pg8::f32x4 a0 = acc[ai][bj][m][0], a1 = acc[ai][bj][m][1];
                    float o[8];
                    o[0] = t0[0] + pg8::sigmoidf_(pg8::bf_lo(gw.x)) * a0[0]; o[1] = t0[1] + pg8::sigmoidf_(pg8::bf_hi(gw.x)) * a0[1];
                    o[2] = t0[2] + pg8::sigmoidf_(pg8::bf_lo(gw.y)) * a0[2]; o[3] = t0[3] + pg8::sigmoidf_(pg8::bf_hi(gw.y)) * a0[3];
                    o[4] = t1[0] + pg8::sigmoidf_(pg8::bf_lo(gw.z)) * a1[0]; o[5] = t1[1] + pg8::sigmoidf_(pg8::bf_hi(gw.z)) * a1[1];
                    o[6] = t1[2] + pg8::sigmoidf_(pg8::bf_lo(gw.w)) * a1[2]; o[7] = t1[3] + pg8::sigmoidf_(pg8::bf_hi(gw.w)) * a1[3];
                    pg8::u32x4 w; w.x = pg8::cvt_pk_bf16(o[0], o[1]); w.y = pg8::cvt_pk_bf16(o[2], o[3]); w.z = pg8::cvt_pk_bf16(o[4], o[5]); w.w = pg8::cvt_pk_bf16(o[6], o[7]);
                    *(pg8::u32x4*)(MB + (size_t)row * DM + col) = w; } }
    }
};
struct EpiF32 {
    static constexpr bool PERM = false;
    float* C; int ldc;
    __device__ __forceinline__ void operator()(const pg8::f32x4 (&acc)[2][2][4][2], const pg8::Unit& u, int wr, int wc, int fr, int fq) const {
        const int row0 = u.pm * 256 + wr * 64 + fr, col0 = u.pn * 256 + wc * 32 + 4 * fq;
#pragma unroll
        for (int ai = 0; ai < 2; ++ai)
#pragma unroll
            for (int m = 0; m < 4; ++m) { float* rp = C + (size_t)(row0 + ai * 128 + m * 16) * ldc + col0;
#pragma unroll
                for (int bj = 0; bj < 2; ++bj)
#pragma unroll
                    for (int n = 0; n < 2; ++n) *(pg8::f32x4*)(rp + bj * 128 + n * 16) = acc[ai][bj][m][n]; }
    }
};
struct EpiRelu2 {
    static constexpr bool PERM = true;
    bf16* C; int ldc;
    __device__ __forceinline__ void operator()(const pg8::f32x4 (&acc)[2][2][4][2], const pg8::Unit& u, int wr, int wc, int fr, int fq) const {
        const int row0 = u.pm * 256 + wr * 64 + fr, col0 = u.pn * 256 + wc * 32 + 8 * fq;
#pragma unroll
        for (int ai = 0; ai < 2; ++ai)
#pragma unroll
            for (int m = 0; m < 4; ++m) { bf16* rp = C + (size_t)(row0 + ai * 128 + m * 16) * ldc + col0;
#pragma unroll
                for (int bj = 0; bj < 2; ++bj) { pg8::f32x4 v0 = acc[ai][bj][m][0], v1 = acc[ai][bj][m][1];
#pragma unroll
                    for (int e = 0; e < 4; ++e) { const float a = fmaxf(v0[e], 0.f), b = fmaxf(v1[e], 0.f); v0[e] = a * a; v1[e] = b * b; }
                    pg8::u32x4 w; w.x = pg8::cvt_pk_bf16(v0[0], v0[1]); w.y = pg8::cvt_pk_bf16(v0[2], v0[3]); w.z = pg8::cvt_pk_bf16(v1[0], v1[1]); w.w = pg8::cvt_pk_bf16(v1[2], v1[3]);
                    *(pg8::u32x4*)(rp + bj * 128) = w; } }
    }
};

__device__ __forceinline__ void p0_transpose_item(const float* W, int K, int N, bf16* WT, int ldk, int koff, LAS float* scr, int item, int lane) {
    const int nblk = N / 32, kb = item / nblk, nb = item % nblk, k0 = 64 * kb, n0 = 32 * nb;
#pragma unroll 8
    for (int i = 0; i < 32; ++i) { const int kk = 2 * i + (lane >> 5); scr[kk * 33 + (lane & 31)] = W[(size_t)(k0 + kk) * N + n0 + (lane & 31)]; }
    LDS_WAIT(); asm volatile("" ::: "memory");
    const int c = lane & 7;
#pragma unroll
    for (int j = 0; j < 4; ++j) { const int n = (lane >> 3) + 8 * j; const LAS float* s = scr + (8 * c) * 33 + n;
        v4u o; o.x = pk2(s[0 * 33], s[1 * 33]); o.y = pk2(s[2 * 33], s[3 * 33]); o.z = pk2(s[4 * 33], s[5 * 33]); o.w = pk2(s[6 * 33], s[7 * 33]);
        *(GAS v4u*)(WT + (size_t)(n0 + n) * ldk + koff + k0 + 8 * c) = o; }
    LDS_WAIT(); asm volatile("" ::: "memory");
}
__device__ __forceinline__ void rms_row_to_bf16(const float* xrow, const float* gain, bf16* orow, int lane) {
    const f32x4* xr = (const f32x4*)xrow + lane; const f32x4* gr = (const f32x4*)gain + lane;
    f32x4 v[4]; float s = 0.f;
#pragma unroll
    for (int j = 0; j < 4; ++j) { v[j] = xr[64 * j]; s += (v[j].x * v[j].x + v[j].y * v[j].y) + (v[j].z * v[j].z + v[j].w * v[j].w); }
    const float rstd = 1.0f / sqrtf(wave_sum(s) * (1.f / DM) + EPS);
    unsigned long long* o8 = (unsigned long long*)orow + lane;
#pragma unroll
    for (int j = 0; j < 4; ++j) { const f32x4 gg = gr[64 * j];
        o8[64 * j] = (unsigned long long)pk2(v[j].x * rstd * gg.x, v[j].y * rstd * gg.y) | ((unsigned long long)pk2(v[j].z * rstd * gg.z, v[j].w * rstd * gg.w) << 32); }
}
__device__ __forceinline__ void p0_prologue(Frame& F) {
    LAS float* scr = (LAS float*)(F.lds + F.wave * 16384);
    const int gw = F.vcu * NWAVES + F.wave, NGW = F.G * NWAVES;
    constexpr int I_IN = (DM / 64) * (NIN / 32), I_ATT = (512 / 64) * (DM / 32), I_RET = (DM / 64) * (DM / 32), I_OUT = I_RET, I_UP = (DM / 64) * (FF / 32), I_DN = (FF / 64) * (DM / 32);
    constexpr int NITEMS = I_IN + I_ATT + I_RET + I_OUT + I_UP + I_DN;
    for (int it = gw; it < NITEMS; it += NGW) {
        int r = it;
        if (r < I_IN) { p0_transpose_item(F.w_in, DM, NIN, F.WIN, DM, 0, scr, r, F.lane); continue; } r -= I_IN;
        if (r < I_ATT) { p0_transpose_item(F.w_att, 512, DM, F.WBR, KBR, 0, scr, r, F.lane); continue; } r -= I_ATT;
        if (r < I_RET) { p0_transpose_item(F.w_ret, DM, DM, F.WBR, KBR, 512, scr, r, F.lane); continue; } r -= I_RET;
        if (r < I_OUT) { p0_transpose_item(F.w_out, DM, DM, F.WOUT, DM, 0, scr, r, F.lane); continue; } r -= I_OUT;
        if (r < I_UP) { p0_transpose_item(F.w_up, DM, FF, F.WUP, DM, 0, scr, r, F.lane); continue; } r -= I_UP;
        p0_transpose_item(F.w_dn, FF, DM, F.WDN, FF, 0, scr, r, F.lane);
    }
    for (int m = gw; m < MPAD; m += NGW) {
        if (m < MREAL) rms_row_to_bf16(xrow_ptr(F, m), F.g_pre_mix, F.XN + (size_t)m * DM, F.lane);
        else { v4u z = {0u, 0u, 0u, 0u}; v4u* o = (v4u*)(F.XN + (size_t)m * DM) + F.lane; o[0] = z; o[64] = z; }
    }
    for (int e = (F.vcu * NWAVES + F.wave) * 64 + F.lane; e < 2049 * 64; e += NGW * 64) {
        const int p = e >> 6, i = e & 63; const double pos = (p == 2048) ? 8192.0 : (double)p;
        const double inv = exp2(-(double)i * (13.287712379549449 / 64.0));
        double sn, cs; sincos(pos * inv, &sn, &cs);
        F.ROPE[2 * e] = (float)cs; F.ROPE[2 * e + 1] = (float)sn;
    }
}

__device__ __forceinline__ float dot128_bf16(const bf16* k, const LAS float* qs) {
    float s = 0.f;
#pragma unroll
    for (int c = 0; c < 16; ++c) { const v4u w = *(const v4u*)(k + 8 * c); const LAS f32x4* q4 = (const LAS f32x4*)(qs + 8 * c); const f32x4 qa = q4[0], qb = q4[1];
        s += pg8::bf_lo(w.x) * qa.x + pg8::bf_hi(w.x) * qa.y + pg8::bf_lo(w.y) * qa.z + pg8::bf_hi(w.y) * qa.w + pg8::bf_lo(w.z) * qb.x + pg8::bf_hi(w.z) * qb.y + pg8::bf_lo(w.w) * qb.z + pg8::bf_hi(w.w) * qb.w; }
    return s;
}
__device__ __forceinline__ float dot128_f32(const float* k, const LAS float* qs) {
    float s = 0.f;
#pragma unroll
    for (int c = 0; c < 32; ++c) { const f32x4 w = *(const f32x4*)(k + 4 * c); const f32x4 q = *(const LAS f32x4*)(qs + 4 * c); s += w.x * q.x + w.y * q.y + w.z * q.z + w.w * q.w; }
    return s;
}
__device__ __forceinline__ void attn_simple_task(const Frame& F, int r, int h, LAS float* qs, LAS float* ps) {
    const int lane = F.lane; const bool samp = r >= MP; const int b = samp ? r - MP : (r >> 11), t = samp ? 0 : (r & 2047);
    float o0[3], o1[3], lse[3];
#pragma unroll
    for (int g = 0; g < 3; ++g) {
        const int d = g == 0 ? 1 : (g == 1 ? 4 : 16), L = 128 * d;
        const float* cache = g == 0 ? F.c1 : (g == 1 ? F.c4 : F.c16);
        { const unsigned qq = *(const unsigned*)(F.Z + (size_t)r * NIN + C_QA + g * 512 + h * 128 + 2 * lane); qs[2 * lane] = pg8::bf_lo(qq); qs[2 * lane + 1] = pg8::bf_hi(qq); }
        LDS_WAIT(); asm volatile("" ::: "memory");
        const int nk = samp ? 129 : ((t / d) < 128 ? (t / d) : 128) + 1;
        float s[3];
#pragma unroll
        for (int jj = 0; jj < 3; ++jj) {
            const int j = jj < 2 ? lane + 64 * jj : 128; const bool valid = (jj < 2 || lane == 0) && j < nk;
            float v = -1e30f;
            if (valid) {
                if (!samp) v = dot128_bf16(F.Z + (size_t)(b * SEQ + t - j * d) * NIN + C_KA + g * 512 + h * 128, qs);
                else if (j == 0) v = dot128_bf16(F.Z + (size_t)r * NIN + C_KA + g * 512 + h * 128, qs);
                else v = dot128_f32(cache + ((size_t)b * L + (L - j * d)) * 1024 + h * 128, qs);
                v *= 0.08838834764831845f;
            }
            s[jj] = v;
        }
        const float mx = wave_max(fmaxf(fmaxf(s[0], s[1]), s[2]));
        float p[3], l = 0.f;
#pragma unroll
        for (int jj = 0; jj < 3; ++jj) { p[jj] = (s[jj] > -1e29f) ? __expf(s[jj] - mx) : 0.f; l += p[jj]; }
        l = wave_sum(l);
        ps[lane] = p[0]; ps[lane + 64] = p[1]; if (lane == 0) ps[128] = p[2];
        LDS_WAIT(); asm volatile("" ::: "memory");
        float a0 = 0.f, a1 = 0.f;
        if (!samp) {
            const bf16* vb = F.Z + (size_t)(b * SEQ + t) * NIN + C_VA + g * 512 + h * 128 + 2 * lane;
            for (int j = 0; j < nk; ++j) { const unsigned w = *(const unsigned*)(vb - (size_t)j * d * NIN); const float pj = ps[j]; a0 += pj * pg8::bf_lo(w); a1 += pj * pg8::bf_hi(w); }
        } else {
            { const unsigned w = *(const unsigned*)(F.Z + (size_t)r * NIN + C_VA + g * 512 + h * 128 + 2 * lane); const float pj = ps[0]; a0 += pj * pg8::bf_lo(w); a1 += pj * pg8::bf_hi(w); }
            for (int j = 1; j < 129; ++j) { const f32x2 w = *(const f32x2*)(cache + ((size_t)b * L + (L - j * d)) * 1024 + 512 + h * 128 + 2 * lane); const float pj = ps[j]; a0 += pj * w.x; a1 += pj * w.y; }
        }
        const float il = 1.0f / l;
        o0[g] = a0 * il; o1[g] = a1 * il; lse[g] = mx + __logf(l);
        LDS_WAIT(); asm volatile("" ::: "memory");
    }
    const float ml = fmaxf(fmaxf(lse[0], lse[1]), lse[2]);
    const float w0 = __expf(lse[0] - ml), w1 = __expf(lse[1] - ml), w2 = __expf(lse[2] - ml), iw = 1.0f / (w0 + w1 + w2);
    const float r0 = (w0 * o0[0] + w1 * o0[1] + w2 * o0[2]) * iw, r1 = (w0 * o1[0] + w1 * o1[1] + w2 * o1[2]) * iw;
    *(unsigned*)(F.ABR + (size_t)r * KBR + h * 128 + 2 * lane) = pk2(r0, r1);
}
__device__ __forceinline__ void ret_simple_task(const Frame& F, int b, int h, bool samp) {
    constexpr int TB = 16;
    LAS float* qk = (LAS float*)F.lds;
    LAS float* red = (LAS float*)(F.lds + 16384);
    const int tid = F.tid, dv = tid & 255, half = tid >> 8;
    const float gamma = 1.0f - exp2f(-5.0f - (float)h);
    float S[64];
    if (samp) {
#pragma unroll
        for (int i = 0; i < 64; ++i) S[i] = F.st0[((size_t)(b * 4 + h) * 128 + half * 64 + i) * 256 + dv];
    } else {
#pragma unroll
        for (int i = 0; i < 64; ++i) S[i] = 0.f;
    }
    const int T = samp ? 1 : SEQ, rowbase = samp ? MP + b : b * SEQ;
    for (int t0 = 0; t0 < T; t0 += TB) {
        const int nb = (T - t0) < TB ? (T - t0) : TB;
        __syncthreads();
        for (int idx = tid; idx < nb * 128; idx += 512) {
            const int tt = idx >> 7, i = idx & 127, which = i >> 6, ii = i & 63, row = rowbase + t0 + tt, pidx = samp ? 2048 : (t0 + tt);
            const bf16* src = F.Z + (size_t)row * NIN + (which ? C_KR : C_QR) + h * 128;
            const float x1 = bf2f(src[ii]), x2 = bf2f(src[ii + 64]);
            const f32x2 cs = *(const f32x2*)(F.ROPE + 2 * (pidx * 64 + ii));
            const float sc = which ? 0.08838834764831845f : 1.0f;
            qk[(tt * 2 + which) * 128 + ii] = (x1 * cs.x - x2 * cs.y) * sc; qk[(tt * 2 + which) * 128 + ii + 64] = (x1 * cs.y + x2 * cs.x) * sc;
        }
        __syncthreads();
        for (int tt = 0; tt < nb; ++tt) {
            const int row = rowbase + t0 + tt;
            const float v = bf2f(F.Z[(size_t)row * NIN + C_VR + h * 256 + dv]);
            const LAS f32x4* q4 = (const LAS f32x4*)(qk + (tt * 2 + 0) * 128 + half * 64); const LAS f32x4* k4 = (const LAS f32x4*)(qk + (tt * 2 + 1) * 128 + half * 64);
            float acc = 0.f;
#pragma unroll
            for (int c = 0; c < 16; ++c) { const f32x4 q = q4[c], k = k4[c];
                S[4 * c + 0] = gamma * S[4 * c + 0] + k.x * v; acc += q.x * S[4 * c + 0];
                S[4 * c + 1] = gamma * S[4 * c + 1] + k.y * v; acc += q.y * S[4 * c + 1];
                S[4 * c + 2] = gamma * S[4 * c + 2] + k.z * v; acc += q.z * S[4 * c + 2];
                S[4 * c + 3] = gamma * S[4 * c + 3] + k.w * v; acc += q.w * S[4 * c + 3]; }
            red[(tt * 2 + half) * 256 + dv] = acc;
        }
        __syncthreads();
        for (int idx = tid; idx < nb * 256; idx += 512) { const int tt = idx >> 8, c = idx & 255;
            F.RO[(size_t)(rowbase + t0 + tt) * DM + h * 256 + c] = red[(tt * 2 + 0) * 256 + c] + red[(tt * 2 + 1) * 256 + c]; }
    }
    float* so = F.out + (samp ? O_STS : O_STP);
#pragma unroll
    for (int i = 0; i < 64; ++i) so[((size_t)(b * 4 + h) * 128 + half * 64 + i) * 256 + dv] = S[i];
    __syncthreads();
}
__device__ __forceinline__ void gn_gate_task(const Frame& F, int r, int h) {
    const int lane = F.lane;
    const f32x4 x = *(const f32x4*)(F.RO + (size_t)r * DM + h * 256 + 4 * lane);
    const float mu = wave_sum((x.x + x.y) + (x.z + x.w)) * (1.f / 256.f);
    const f32x4 d = x - mu;
    const float var = wave_sum((d.x * d.x + d.y * d.y) + (d.z * d.z + d.w * d.w)) * (1.f / 256.f);
    const float rstd = 1.0f / sqrtf(var + EPS);
    const f32x4 gn = *(const f32x4*)(F.g_ret + h * 256 + 4 * lane);
    const v2u gw = *(const v2u*)(F.Z + (size_t)r * NIN + C_GR + h * 256 + 4 * lane);
    const float g0 = pg8::bf_lo(gw.x), g1 = pg8::bf_hi(gw.x), g2 = pg8::bf_lo(gw.y), g3 = pg8::bf_hi(gw.y);
    const float y0 = g0 * pg8::sigmoidf_(g0) * (d.x * rstd * gn.x), y1 = g1 * pg8::sigmoidf_(g1) * (d.y * rstd * gn.y);
    const float y2 = g2 * pg8::sigmoidf_(g2) * (d.z * rstd * gn.z), y3 = g3 * pg8::sigmoidf_(g3) * (d.w * rstd * gn.w);
    v2u o; o.x = pk2(y0, y1); o.y = pk2(y2, y3);
    *(v2u*)(F.ABR + (size_t)r * KBR + 512 + h * 256 + 4 * lane) = o;
}

__device__ __forceinline__ void mix_norm_row(const Frame& F, int r) {
    const int lane = F.lane;
    const f32x4* orow = (const f32x4*)(F.O + (size_t)r * DM) + lane; const f32x4* xr = (const f32x4*)xrow_ptr(F, r) + lane;
    const f32x4* g1 = (const f32x4*)F.g_post_mix + lane; const f32x4* g2 = (const f32x4*)F.g_pre_mlp + lane;
    f32x4 o[4], x[4]; float s = 0.f;
#pragma unroll
    for (int j = 0; j < 4; ++j) { o[j] = orow[64 * j]; x[j] = xr[64 * j]; s += (o[j].x * o[j].x + o[j].y * o[j].y) + (o[j].z * o[j].z + o[j].w * o[j].w); }
    const float rstd = 1.0f / sqrtf(wave_sum(s) * (1.f / DM) + EPS);
    float s2 = 0.f;
#pragma unroll
    for (int j = 0; j < 4; ++j) { x[j] = x[j] + o[j] * rstd * g1[64 * j]; s2 += (x[j].x * x[j].x + x[j].y * x[j].y) + (x[j].z * x[j].z + x[j].w * x[j].w); }
    const float rstd2 = 1.0f / sqrtf(wave_sum(s2) * (1.f / DM) + EPS);
    f32x4* yr = (f32x4*)(F.out + O_Y + (size_t)r * DM) + lane;
    unsigned long long* o8 = (unsigned long long*)(F.XN2 + (size_t)r * DM) + lane;
#pragma unroll
    for (int j = 0; j < 4; ++j) { yr[64 * j] = x[j]; const f32x4 gg = g2[64 * j];
        o8[64 * j] = (unsigned long long)pk2(x[j].x * rstd2 * gg.x, x[j].y * rstd2 * gg.y) | ((unsigned long long)pk2(x[j].z * rstd2 * gg.z, x[j].w * rstd2 * gg.w) << 32); }
}
__device__ __forceinline__ void mlp_norm_row(const Frame& F, int r) {
    const int lane = F.lane;
    const f32x4* drow = (const f32x4*)(F.DN + (size_t)r * DM) + lane; f32x4* yr = (f32x4*)(F.out + O_Y + (size_t)r * DM) + lane; const f32x4* g3 = (const f32x4*)F.g_post_mlp + lane;
    f32x4 d[4]; float s = 0.f;
#pragma unroll
    for (int j = 0; j < 4; ++j) { d[j] = drow[64 * j]; s += (d[j].x * d[j].x + d[j].y * d[j].y) + (d[j].z * d[j].z + d[j].w * d[j].w); }
    const float rstd = 1.0f / sqrtf(wave_sum(s) * (1.f / DM) + EPS);
#pragma unroll
    for (int j = 0; j < 4; ++j) yr[64 * j] = yr[64 * j] + d[j] * rstd * g3[64 * j];
}

constexpr int N_PHASES = 11;
struct Args { const float* in[17]; float* out; unsigned char* ws; int ph_lo, ph_hi; };
__global__ void __launch_bounds__(NWAVES * 64, 2) fwd_kernel(Args args) {
    extern __shared__ __attribute__((aligned(16))) unsigned char lds[];
    Frame F;
    F.lds = (LAS unsigned char*)lds;
    volatile LAS unsigned* MISC = (volatile LAS unsigned*)(F.lds + MISC_OFF);
    F.tid = threadIdx.x; F.lane = F.tid & 63; F.wave = __builtin_amdgcn_readfirstlane(F.tid >> 6);
    F.G = gridDim.x; { const int bx = blockIdx.x; F.vcu = (F.G % 8 == 0) ? (bx % 8) * (F.G / 8) + bx / 8 : bx; }
    unsigned char* ws = args.ws;
    F.xp = args.in[0]; F.xs = args.in[1]; F.c1 = args.in[2]; F.c4 = args.in[3]; F.c16 = args.in[4]; F.st0 = args.in[5];
    F.w_in = args.in[6]; F.w_att = args.in[7]; F.w_ret = args.in[8]; F.w_out = args.in[9]; F.w_up = args.in[10]; F.w_dn = args.in[11];
    F.g_ret = args.in[12]; F.g_pre_mix = args.in[13]; F.g_post_mix = args.in[14]; F.g_pre_mlp = args.in[15]; F.g_post_mlp = args.in[16];
    F.out = args.out;
    F.WIN = (bf16*)(ws + WS_WIN); F.WBR = (bf16*)(ws + WS_WBR); F.WOUT = (bf16*)(ws + WS_WOUT); F.WUP = (bf16*)(ws + WS_WUP); F.WDN = (bf16*)(ws + WS_WDN);
    F.ROPE = (float*)(ws + WS_ROPE); F.XN = (bf16*)(ws + WS_XN); F.Z = (bf16*)(ws + WS_Z); F.ABR = (bf16*)(ws + WS_ABR); F.RO = (float*)(ws + WS_RO);
    F.T1 = (float*)(ws + WS_T1); F.MB = (bf16*)(ws + WS_MB); F.O = (float*)(ws + WS_O); F.XN2 = (bf16*)(ws + WS_XN2); F.U = (bf16*)(ws + WS_U); F.DN = (float*)(ws + WS_DN);
    for (int u = F.tid; u < (LDS_BYTES - LDSCTL_OFF) / 4; u += NWAVES * 64) ((LAS unsigned*)(F.lds + LDSCTL_OFF))[u] = 0u;
    __syncthreads();
    const bool single = (args.ph_lo == 0 && args.ph_hi == N_PHASES);
    XcdBarrier bar; bar.bar = (unsigned*)(ws + WS_CTL) + CW_BAR; bar.x = 0; bar.st = nullptr;
    if (single) bar = xcd_barrier_post((unsigned*)(ws + WS_CTL) + CW_BAR, MISC + 8);
    const int lo = args.ph_lo, hi = args.ph_hi;
#define IN(k) (lo <= (k) && (k) < hi)
#define SEAM(k) do { if (IN(k) && IN((k) + 1)) xcd_barrier(bar); } while (0)
    const int gw = F.vcu * NWAVES + F.wave, NGW = F.G * NWAVES;

    if (IN(0)) { p0_prologue(F); SEAM(0); }
    if (IN(1)) {
        pg8::Gemm g{F.XN, F.WIN, MPAD, NIN, DM, DM, DM}; pg8::StaticOrder S; S.init(MPAD, NIN, F.G, (int)blockIdx.x);
        EpiZ E{F.Z, F.out};
        pg8::gemm_phase<true>(F.lds, g, S, E);
        SEAM(1);
    }
    if (IN(2)) {
        if ((int)blockIdx.x < 32) ret_simple_task(F, (int)blockIdx.x >> 2, (int)blockIdx.x & 3, false);
        for (int it = (int)blockIdx.x; it < 512; it += F.G) ret_simple_task(F, it >> 2, it & 3, true);
        __syncthreads();
        LAS float* qs = (LAS float*)(F.lds + F.wave * 2048); LAS float* ps = qs + 128;
        const int NA = F.G > 32 ? (F.G - 32) * NWAVES : NGW, ga = F.G > 32 ? ((int)blockIdx.x - 32) * NWAVES + F.wave : gw;
        if (ga >= 0) for (int it = ga; it < MREAL * 4; it += NA) attn_simple_task(F, it >> 2, it & 3, qs, ps);
        SEAM(2);
    }
    if (IN(3)) {
        for (int it = gw; it < MREAL * 4; it += NGW) gn_gate_task(F, it >> 2, it & 3);
        SEAM(3);
    }
    if (IN(4)) {
        pg8::Gemm g{F.ABR, F.WBR, MPAD, DM, 512, KBR, KBR}; pg8::StaticOrder S; S.init(MPAD, DM, F.G, (int)blockIdx.x);
        EpiGateA E{F.Z, F.T1};
        pg8::gemm_phase<true>(F.lds, g, S, E);
        SEAM(4);
    }
    if (IN(5)) {
        pg8::Gemm g{F.ABR + 512, F.WBR + 512, MPAD, DM, DM, KBR, KBR}; pg8::StaticOrder S; S.init(MPAD, DM, F.G, (int)blockIdx.x);
        EpiGateR E{F.Z, F.T1, F.MB};
        pg8::gemm_phase<true>(F.lds, g, S, E);
        SEAM(5);
    }
    if (IN(6)) {
        pg8::Gemm g{F.MB, F.WOUT, MPAD, DM, DM, DM, DM}; pg8::StaticOrder S; S.init(MPAD, DM, F.G, (int)blockIdx.x);
        EpiF32 E{F.O, DM};
        pg8::gemm_phase<true>(F.lds, g, S, E);
        SEAM(6);
    }
    if (IN(7)) {
        for (int m = gw; m < MPAD; m += NGW) {
            if (m < MREAL) mix_norm_row(F, m);
            else { v4u z = {0u, 0u, 0u, 0u}; v4u* o = (v4u*)(F.XN2 + (size_t)m * DM) + F.lane; o[0] = z; o[64] = z; }
        }
        SEAM(7);
    }
    if (IN(8)) {
        pg8::Gemm g{F.XN2, F.WUP, MPAD, FF, DM, DM, DM}; pg8::StaticOrder S; S.init(MPAD, FF, F.G, (int)blockIdx.x);
        EpiRelu2 E{F.U, FF};
        pg8::gemm_phase<true>(F.lds, g, S, E);
        SEAM(8);
    }
    if (IN(9)) {
        pg8::Gemm g{F.U, F.WDN, MPAD, DM, FF, FF, FF}; pg8::StaticOrder S; S.init(MPAD, DM, F.G, (int)blockIdx.x);
        EpiF32 E{F.DN, DM};
        pg8::gemm_phase<true>(F.lds, g, S, E);
        SEAM(9);
    }
    if (IN(10)) {
        for (int m = gw; m < MREAL; m += NGW) mlp_norm_row(F, m);
    }
#undef IN
#undef SEAM
}

#ifndef MK_PER_PHASE
#define MK_PER_PHASE 0
#endif
extern "C" void kernel_launch(void* const* d_in, const int* in_sizes, int n_in, void* d_out, int out_size, void* d_ws, size_t ws_size, hipStream_t stream) {
    static int grid = 0;
    if (grid == 0) {
        if (n_in != 17 || out_size != (int)O_END || ws_size < WS_END) { fprintf(stderr, "kernel_launch: unexpected shapes (n_in %d out %d ws %zu)\n", n_in, out_size, ws_size); grid = -1; return; }
        int dev = 0, cus = 0, per_cu = 0;
        if (hipGetDevice(&dev) != hipSuccess || hipDeviceGetAttribute(&cus, hipDeviceAttributeMultiprocessorCount, dev) != hipSuccess) { grid = -1; return; }
        if (hipFuncSetAttribute((const void*)fwd_kernel, hipFuncAttributeMaxDynamicSharedMemorySize, LDS_BYTES) != hipSuccess) { fprintf(stderr, "kernel_launch: hipFuncSetAttribute failed\n"); grid = -1; return; }
        if (hipOccupancyMaxActiveBlocksPerMultiprocessor(&per_cu, (const void*)fwd_kernel, NWAVES * 64, LDS_BYTES) != hipSuccess || per_cu < 1) { fprintf(stderr, "kernel_launch: occupancy query says %d\n", per_cu); }
        (void)hipGetLastError();
        grid = cus;
    }
    if (grid < 0) return;
    (void)hipMemsetAsync((char*)d_ws + WS_CTL, 0, CTL_ZERO_BYTES, stream);
    Args a{};
    for (int i = 0; i < 17; ++i) a.in[i] = (const float*)d_in[i];
    a.out = (float*)d_out; a.ws = (unsigned char*)d_ws;
#if MK_PER_PHASE
    for (int p = 0; p < N_PHASES; ++p) { a.ph_lo = p; a.ph_hi = p + 1; hipLaunchKernelGGL(fwd_kernel, dim3(grid), dim3(NWAVES * 64), LDS_BYTES, stream, a); }
#else
    a.ph_lo = 0; a.ph_hi = N_PHASES;
    hipLaunchKernelGGL(fwd_kernel, dim3(grid), dim3(NWAVES * 64), LDS_BYTES, stream, a);
#endif
}
```

```cpp
#include <hip/hip_runtime.h>
#include <cstdio>
#include <cstdint>

namespace pg8 {
#define PG8_LAS __attribute__((address_space(3)))
typedef unsigned short bf16_t;
typedef short bf16x8 __attribute__((ext_vector_type(8)));
typedef float f32x4 __attribute__((ext_vector_type(4)));
typedef unsigned u32x4 __attribute__((ext_vector_type(4)));
typedef unsigned u32x2 __attribute__((ext_vector_type(2)));
constexpr int BM = 256, BK = 64, HALF = 128, HTB = HALF * BK * 2, STAGE_BYTES = 8 * HTB, NXCD = 8, WGM = 8;

__host__ __device__ __forceinline__ int lds_byte(int r, int c) { const int st = (r >> 4) * 2 + (c >> 5), rr = r & 15, cc = c & 31, ob = rr * 64 + cc * 2; return st * 1024 + (ob ^ (((ob >> 9) & 1) << 5)); }
__host__ __device__ __forceinline__ void stage_rc(int b, int& R, int& C) { const int st = b / 1024, sb = b % 1024, swz = sb ^ (((sb >> 9) & 1) << 5); R = (st >> 1) * 16 + swz / 64; C = (st & 1) * 32 + (swz % 64) / 2; }
__host__ __device__ __forceinline__ int perm32(int rho) { const int n = rho >> 4, i = rho & 15; return 8 * (i >> 2) + 4 * n + (i & 3); }

struct Unit { int pm, pn; };
struct Gemm { const bf16_t* A; const bf16_t* Bt; int M, N, K, lda, ldb; };

struct StaticOrder {
    int nM, nN, nwg, G, c;
    __host__ __device__ void init(int M, int N, int G_, int c_) { nM = M / BM; nN = N / BM; nwg = nM * nN; G = G_; c = c_; }
    __host__ __device__ bool next(int i, Unit& u) const {
        const long L = (long)i * G + c; if (L >= nwg) return false;
        int wgid = (int)L; { const int q = nwg / NXCD, r = nwg % NXCD, xcd = wgid % NXCD, off = wgid / NXCD; wgid = (xcd < r ? xcd * (q + 1) : r * (q + 1) + (xcd - r) * q) + off; }
        const int nig = WGM * nN, gid = wgid / nig, fm = gid * WGM, gsz = (nM - fm) < WGM ? (nM - fm) : WGM;
        u.pm = fm + ((wgid % nig) % gsz); u.pn = (wgid % nig) / gsz; return true;
    }
};

__device__ __forceinline__ unsigned cvt_pk_bf16(float lo, float hi) { unsigned r; asm volatile("v_cvt_pk_bf16_f32 %0, %1, %2" : "=v"(r) : "v"(lo), "v"(hi)); return r; }
__device__ __forceinline__ float bf_lo(unsigned w) { return __uint_as_float(w << 16); }
__device__ __forceinline__ float bf_hi(unsigned w) { return __uint_as_float(w & 0xffff0000u); }
__device__ __forceinline__ float sigmoidf_(float x) { return 1.0f / (1.0f + __expf(-x)); }


template <bool ALIGN_EPI, class Epi>
__device__ __forceinline__ void gemm_phase(PG8_LAS unsigned char* lds, const Gemm g, const StaticOrder& S, const Epi& E) {
    const int tid = threadIdx.x, wid = __builtin_amdgcn_readfirstlane(tid >> 6), lane = tid & 63, wr = wid >> 2, wc = wid & 3, fr = lane & 15, fq = lane >> 4;
    const int K = g.K, nt = K / BK;
    unsigned voffA[2], voffB[2];
#pragma unroll
    for (int i = 0; i < 2; ++i) { int R, C; stage_rc(tid * 16 + i * 8192, R, C); const int Rb = Epi::PERM ? ((R & ~31) + perm32(R & 31)) : R;
        voffA[i] = (unsigned)(R * g.lda + C) * 2u; voffB[i] = (unsigned)(Rb * g.ldb + C) * 2u; }
    const size_t kstep = (size_t)(BK * 2);
    const size_t hstepA = (size_t)HALF * g.lda * 2, hstepB = (size_t)HALF * g.ldb * 2;
    const size_t tstepA = 2 * hstepA, tstepB = 2 * hstepB;
    const unsigned ldsw = (unsigned)wid * 1024u;
    const int aoff = lds_byte(wr * 64 + fr, fq * 8), boff = lds_byte(wc * 32 + fr, fq * 8);
#define PG8_SA(b, h) (((b) * 2 + (h)) * HTB)
#define PG8_SB(b, h) ((4 + (b) * 2 + (h)) * HTB)
#define PG8_STAGE(bufoff, gbase, voff) do { _Pragma("unroll") for (int _i = 0; _i < 2; ++_i) \
        __builtin_amdgcn_global_load_lds((const unsigned*)((const char*)(gbase) + (voff)[_i]), (PG8_LAS unsigned*)(lds + (bufoff) + ldsw + _i * 8192), 16, 0, 0); } while (0)
#define PG8_LDA(dst, b, h) do { _Pragma("unroll") for (int m = 0; m < 4; ++m) _Pragma("unroll") for (int k = 0; k < 2; ++k) dst[m][k] = *(const PG8_LAS bf16x8*)(lds + PG8_SA(b, h) + aoff + m * 2048 + k * 1024); } while (0)
#define PG8_LDB(dst, b, h) do { _Pragma("unroll") for (int n = 0; n < 2; ++n) _Pragma("unroll") for (int k = 0; k < 2; ++k) dst[n][k] = *(const PG8_LAS bf16x8*)(lds + PG8_SB(b, h) + boff + n * 2048 + k * 1024); } while (0)
#define PG8_MMA(ai, bj, At, Bt) do { __builtin_amdgcn_s_setprio(1); _Pragma("unroll") for (int m = 0; m < 4; ++m) _Pragma("unroll") for (int n = 0; n < 2; ++n) _Pragma("unroll") for (int k = 0; k < 2; ++k) \
        acc[ai][bj][m][n] = __builtin_amdgcn_mfma_f32_16x16x32_bf16(Bt[n][k], At[m][k], acc[ai][bj][m][n], 0, 0, 0); __builtin_amdgcn_s_setprio(0); } while (0)
#define PG8_WAIT_V(n) asm volatile("s_waitcnt vmcnt(" #n ")" ::: "memory")
#define PG8_WAIT_L(n) asm volatile("s_waitcnt lgkmcnt(" #n ")" ::: "memory")
#define PG8_BAR __builtin_amdgcn_s_barrier()
#define PG8_SCHED __builtin_amdgcn_sched_barrier(0)
    Unit cur, nxt; int ui = 0;
    if (!S.next(0, cur)) return;
    f32x4 acc[2][2][4][2];
#pragma unroll
    for (int a = 0; a < 2; ++a)
#pragma unroll
        for (int b = 0; b < 2; ++b)
#pragma unroll
            for (int m = 0; m < 4; ++m)
#pragma unroll
                for (int n = 0; n < 2; ++n) acc[a][b][m][n] = (f32x4){0.f, 0.f, 0.f, 0.f};
    bf16x8 At[4][2], B0[2][2], B1[2][2];
    const char* cA = (const char*)g.A + (size_t)cur.pm * tstepA; const char* cB = (const char*)g.Bt + (size_t)cur.pn * tstepB;
    PG8_STAGE(PG8_SB(0, 0), cB, voffB); PG8_STAGE(PG8_SB(0, 1), cB + hstepB, voffB); PG8_STAGE(PG8_SA(0, 0), cA, voffA); PG8_STAGE(PG8_SA(0, 1), cA + hstepA, voffA);
    if (wr == 1) PG8_BAR;
    PG8_WAIT_V(2); PG8_BAR;
    PG8_STAGE(PG8_SB(1, 0), cB + kstep, voffB); PG8_STAGE(PG8_SA(1, 0), cA + kstep, voffA); PG8_STAGE(PG8_SB(1, 1), cB + hstepB + kstep, voffB);
    PG8_WAIT_V(6); PG8_BAR;
    for (;;) {
        const bool has_next = S.next(ui + 1, nxt);
        const char* nA = has_next ? (const char*)g.A + (size_t)nxt.pm * tstepA : cA; const char* nB = has_next ? (const char*)g.Bt + (size_t)nxt.pn * tstepB : cB;
        for (int t = 0; t < nt; t += 2) {
            const bool last = (t == nt - 2);
            const char* a1 = cA + (size_t)(t + 1) * kstep;
            const char* a2 = last ? nA : cA + (size_t)(t + 2) * kstep; const char* b2 = last ? nB : cB + (size_t)(t + 2) * kstep;
            const char* a3 = a2 + kstep; const char* b3 = b2 + kstep;
            PG8_LDB(B0, 0, 0); PG8_LDB(B1, 0, 1); PG8_SCHED; PG8_LDA(At, 0, 0); PG8_STAGE(PG8_SA(1, 1), a1 + hstepA, voffA);
            PG8_WAIT_V(8); PG8_WAIT_L(0); PG8_BAR; PG8_MMA(0, 0, At, B0); PG8_MMA(0, 1, At, B1); PG8_BAR; PG8_SCHED;
            PG8_LDA(At, 0, 1); PG8_STAGE(PG8_SB(0, 0), b2, voffB); PG8_STAGE(PG8_SB(0, 1), b2 + hstepB, voffB); PG8_STAGE(PG8_SA(0, 0), a2, voffA);
            PG8_WAIT_V(8); PG8_WAIT_L(0); PG8_BAR; PG8_MMA(1, 0, At, B0); PG8_MMA(1, 1, At, B1); PG8_BAR; PG8_SCHED;
            PG8_LDB(B0, 1, 0); PG8_LDB(B1, 1, 1); PG8_SCHED; PG8_LDA(At, 1, 0); PG8_STAGE(PG8_SA(0, 1), a2 + hstepA, voffA);
            PG8_WAIT_V(8); PG8_WAIT_L(0); PG8_BAR; PG8_MMA(0, 0, At, B0); PG8_MMA(0, 1, At, B1); PG8_BAR; PG8_SCHED;
            PG8_LDA(At, 1, 1); PG8_STAGE(PG8_SB(1, 0), b3, voffB); PG8_STAGE(PG8_SB(1, 1), b3 + hstepB, voffB); PG8_STAGE(PG8_SA(1, 0), a3, voffA);
            PG8_WAIT_V(8); PG8_WAIT_L(0); PG8_BAR; PG8_MMA(1, 0, At, B0); PG8_MMA(1, 1, At, B1); PG8_BAR; PG8_SCHED;
        }
        if constexpr (ALIGN_EPI) { if (wr == 0) PG8_BAR; }
        E(acc, cur, wr, wc, fr, fq);
        if (!has_next) break;
#pragma unroll
        for (int a = 0; a < 2; ++a)
#pragma unroll
            for (int b = 0; b < 2; ++b)
#pragma unroll
                for (int m = 0; m < 4; ++m)
#pragma unroll
                    for (int n = 0; n < 2; ++n) acc[a][b][m][n] = (f32x4){0.f, 0.f, 0.f, 0.f};
        cur = nxt; cA = nA; cB = nB; ++ui;
        if constexpr (ALIGN_EPI) { if (wr == 1) PG8_BAR; }
    }
    PG8_WAIT_V(0);
    if constexpr (!ALIGN_EPI) { if (wr == 0) PG8_BAR; }
    PG8_BAR;
#undef PG8_SA
#undef PG8_SB
#undef PG8_STAGE
#undef PG8_LDA
#undef PG8_LDB
#undef PG8_MMA
#undef PG8_WAIT_V
#undef PG8_WAIT_L
#undef PG8_BAR
#undef PG8_SCHED
}
}

constexpr int NWAVES = 8;
constexpr int DM = 1024, SEQ = 2048, NB = 8, MP = NB * SEQ  , MS = 128, MREAL = MP + MS  , MPAD = 16640  ;
constexpr int NIN = 9728, FF = 4096, KBR = 1536;
constexpr int C_QA = 0, C_KA = 1536, C_VA = 3072, C_QR = 4608, C_KR = 5120, C_VR = 5632, C_GR = 6656, C_GA = 7680, C_GRT = 8704;
constexpr float EPS = 1e-6f;
constexpr size_t O_Y = 0, O_KV1P = 16908288, O_KV4P = O_KV1P + 1048576, O_KV16P = O_KV4P + 4194304, O_STP = O_KV16P + 16777216,
                 O_KV1S = O_STP + 1048576, O_KV4S = O_KV1S + 131072, O_KV16S = O_KV4S + 131072, O_STS = O_KV16S + 131072, O_END = O_STS + 16777216;
static_assert(O_END == 57147392, "d_out map");

constexpr size_t MiB = 1u << 20;
constexpr size_t WS_CTL = 0, CTL_ZERO_BYTES = 64 * 1024;
constexpr size_t WS_WIN = 2 * MiB;
constexpr size_t WS_WBR = 22 * MiB;
constexpr size_t WS_WOUT = 26 * MiB;
constexpr size_t WS_WUP = 28 * MiB;
constexpr size_t WS_WDN = 36 * MiB;
constexpr size_t WS_ROPE = 44 * MiB;
constexpr size_t WS_XN = 46 * MiB;
constexpr size_t WS_Z = 80 * MiB;
constexpr size_t WS_ABR = 390 * MiB;
constexpr size_t WS_RO = 440 * MiB;
constexpr size_t WS_T1 = 506 * MiB;
constexpr size_t WS_MB = 572 * MiB;
constexpr size_t WS_O = 606 * MiB;
constexpr size_t WS_XN2 = 672 * MiB;
constexpr size_t WS_U = 706 * MiB;
constexpr size_t WS_DN = 838 * MiB;
constexpr size_t WS_OG = 904 * MiB;
constexpr size_t WS_LSE = 954 * MiB;
constexpr size_t WS_UT = 956 * MiB;
constexpr size_t WS_END = 990 * MiB;
constexpr int CW_BAR = 1024;

constexpr int RING_BYTES = 139264, LDSCTL_OFF = RING_BYTES, MISC_OFF = LDSCTL_OFF + 320, LDS_BYTES = 147456;
constexpr int RS = 272, VS = 528;

#define GAS __attribute__((address_space(1)))
#define LAS __attribute__((address_space(3)))
typedef unsigned short bf16;
typedef unsigned v4u __attribute__((ext_vector_type(4)));
typedef unsigned v2u __attribute__((ext_vector_type(2)));
typedef float f32x4 __attribute__((ext_vector_type(4)));
typedef float f32x2 __attribute__((ext_vector_type(2)));
#define LDS_WAIT() asm volatile("s_waitcnt lgkmcnt(0)" ::: "memory")
__device__ __forceinline__ unsigned f2bf(float f) { unsigned u = __builtin_bit_cast(unsigned, f); return (u + 0x7fffu + ((u >> 16) & 1u)) >> 16; }
__device__ __forceinline__ unsigned pk2(float lo, float hi) { return f2bf(lo) | (f2bf(hi) << 16); }
__device__ __forceinline__ float bf2f(unsigned short b) { return __uint_as_float((unsigned)b << 16); }

#define XB_TMO      128
#define XB_XCNT(j)  (256  + 64 * (j))
#define XB_XSUB(j)  (1280 + 64 * (j))
#define XB_XGEN(j)  (2304 + 64 * (j))
#define XB_TOP      3328
#define XB_TOPGEN   3392
#define XCD_BAR_WORDS 3456
#define XB_SPIN_CAP (1u << 18)
__device__ __forceinline__ unsigned xb_ld(unsigned* p)              { return __hip_atomic_load(p, __ATOMIC_RELAXED, __HIP_MEMORY_SCOPE_AGENT); }
__device__ __forceinline__ unsigned xb_add(unsigned* p, unsigned v) { return __hip_atomic_fetch_add(p, v, __ATOMIC_RELAXED, __HIP_MEMORY_SCOPE_AGENT); }
__device__ __forceinline__ unsigned xb_xcc_id() { return (unsigned)__builtin_amdgcn_s_getreg((3 << 11) | 20) & 0xFu; }
#define XB_SPIN(cond, bar) do { unsigned _sp = 0; while (cond) { __builtin_amdgcn_s_sleep(1); \
    if ((++_sp & 255u) == 0u) { if (xb_ld(&(bar)[XB_TMO])) break; if (_sp > XB_SPIN_CAP) { atomicAdd(&(bar)[XB_TMO], 1u); break; } } } } while (0)
struct XcdBarrier { unsigned* bar; unsigned x; volatile LAS unsigned* st; };
__device__ __forceinline__ XcdBarrier xcd_barrier_post(unsigned* bar, volatile LAS unsigned* st) {
    XcdBarrier b; b.bar = bar; b.x = xb_xcc_id(); b.st = st;
    if (threadIdx.x == 0) (void)xb_add(&bar[XB_XCNT(b.x)], 1u);
    return b;
}
__device__ __forceinline__ void xcd_barrier_complete(unsigned* bar, unsigned x, unsigned& nloc, unsigned& nx) {
    const unsigned G = gridDim.x * gridDim.y * gridDim.z;
    unsigned sum, cnt, mine, sp = 0u;
    for (;;) {
        sum = 0u; cnt = 0u; mine = 0u;
#pragma unroll
        for (unsigned j = 0; j < 16; ++j) { const unsigned c = xb_ld(&bar[XB_XCNT(j)]); sum += c; cnt += (c > 0u) ? 1u : 0u; mine = (j == x) ? c : mine; }
        if (sum == G) break;
        __builtin_amdgcn_s_sleep(1);
        if ((++sp & 255u) == 0u) { if (xb_ld(&bar[XB_TMO])) break; if (sp > XB_SPIN_CAP) { atomicAdd(&bar[XB_TMO], 1u); break; } }
    }
    nloc = mine > 0u ? mine : 1u; nx = cnt > 0u ? cnt : 1u;
}
__device__ __forceinline__ void xcd_barrier(const XcdBarrier& b) {
    asm volatile("s_waitcnt vmcnt(0)" ::: "memory");
    __syncthreads();
    if (threadIdx.x == 0) {
        unsigned* bar = b.bar;
        __builtin_amdgcn_s_waitcnt(0);
        unsigned nloc = b.st[0], nx = b.st[1];
        if (nloc == 0u) { xcd_barrier_complete(bar, b.x, nloc, nx); b.st[0] = nloc; b.st[1] = nx; }
        const unsigned old = xb_add(&bar[XB_XSUB(b.x)], 1u);
        const unsigned gen = old / nloc;
        if (old + 1u == (gen + 1u) * nloc) {
            __builtin_amdgcn_fence(__ATOMIC_RELEASE, "agent");
            asm volatile("s_waitcnt vmcnt(0)" ::: "memory");
            const unsigned og = xb_add(&bar[XB_TOP], 1u);
            const unsigned tg = og / nx;
            if (og + 1u == (tg + 1u) * nx) xb_add(&bar[XB_TOPGEN], 1u);
            else XB_SPIN(xb_ld(&bar[XB_TOPGEN]) == tg, bar);
            __builtin_amdgcn_fence(__ATOMIC_ACQUIRE, "agent");
            xb_add(&bar[XB_XGEN(b.x)], 1u);
            asm volatile("s_waitcnt vmcnt(0)" ::: "memory");
        } else {
            XB_SPIN(xb_ld(&bar[XB_XGEN(b.x)]) == gen, bar);
            __builtin_amdgcn_fence(__ATOMIC_ACQUIRE, "agent");
            asm volatile("s_waitcnt vmcnt(0)" ::: "memory");
        }
    }
    __syncthreads();
}

struct Frame {
    LAS unsigned char* lds;
    int tid, lane, wave, G, vcu;
    const float *xp, *xs, *c1, *c4, *c16, *st0, *w_in, *w_att, *w_ret, *w_out, *w_up, *w_dn, *g_ret, *g_pre_mix, *g_post_mix, *g_pre_mlp, *g_post_mlp;
    float* out;
    bf16 *WIN, *WBR, *WOUT, *WUP, *WDN, *XN, *Z, *ABR, *MB, *XN2, *U;
    float *ROPE, *RO, *T1, *O, *DN, *LSE;
    bf16 *OG, *UT;
};
__device__ __forceinline__ const float* xrow_ptr(const Frame& F, int r) { return r < MP ? F.xp + (size_t)r * DM : F.xs + (size_t)(r - MP) * DM; }
__device__ __forceinline__ float wave_sum(float v) {
#pragma unroll
    for (int o = 1; o < 64; o <<= 1) v += __shfl_xor(v, o);
    return v;
}
__device__ __forceinline__ float wave_max(float v) {
#pragma unroll
    for (int o = 1; o < 64; o <<= 1) v = fmaxf(v, __shfl_xor(v, o));
    return v;
}

struct EpiZ {
    static constexpr bool PERM = true;
    bf16* Z; float* out;
    __device__ __forceinline__ void operator()(const pg8::f32x4 (&acc)[2][2][4][2], const pg8::Unit& u, int wr, int wc, int fr, int fq) const {
        const int row0 = u.pm * 256 + wr * 64 + fr, colt = u.pn * 256, cw = wc * 32 + 8 * fq;
        const bool iskv = (colt >= C_KA && colt < C_QR);
        int kv = 0, g = 0, cc0 = 0;
        if (iskv) { const int c = colt - C_KA; kv = c / 1536; g = (c % 1536) / 512; cc0 = (c % 512) + cw; }
        const int L = g == 0 ? 128 : (g == 1 ? 512 : 2048);
        const size_t offp = g == 0 ? O_KV1P : (g == 1 ? O_KV4P : O_KV16P), offs = g == 0 ? O_KV1S : (g == 1 ? O_KV4S : O_KV16S);
#pragma unroll
        for (int ai = 0; ai < 2; ++ai)
#pragma unroll
            for (int m = 0; m < 4; ++m) {
                const int row = row0 + ai * 128 + m * 16;
                bf16* zp = Z + (size_t)row * NIN + colt + cw;
                float* kp = nullptr;
                if (iskv) {
                    if (row < MP) { const int b = row >> 11, t = row & 2047; if (t >= SEQ - L) kp = out + offp + ((size_t)(b * L + (t - (SEQ - L)))) * 1024 + kv * 512 + cc0; }
                    else if (row < MREAL) kp = out + offs + (size_t)(row - MP) * 1024 + kv * 512 + cc0;
                }
#pragma unroll
                for (int bj = 0; bj < 2; ++bj) {
                    const pg8::f32x4 v0 = acc[ai][bj][m][0], v1 = acc[ai][bj][m][1];
                    pg8::u32x4 w; w.x = pg8::cvt_pk_bf16(v0[0], v0[1]); w.y = pg8::cvt_pk_bf16(v0[2], v0[3]); w.z = pg8::cvt_pk_bf16(v1[0], v1[1]); w.w = pg8::cvt_pk_bf16(v1[2], v1[3]);
                    *(pg8::u32x4*)(zp + bj * 128) = w;
                    if (kp) { *(pg8::f32x4*)(kp + bj * 128) = v0; *(pg8::f32x4*)(kp + bj * 128 + 4) = v1; }
                }
            }
    }
};
struct EpiGateA {
    static constexpr bool PERM = false;
    const bf16* Z; float* T1;
    __device__ __forceinline__ void operator()(const pg8::f32x4 (&acc)[2][2][4][2], const pg8::Unit& u, int wr, int wc, int fr, int fq) const {
        const int row0 = u.pm * 256 + wr * 64 + fr, col0 = u.pn * 256 + wc * 32 + 4 * fq;
#pragma unroll
        for (int ai = 0; ai < 2; ++ai)
#pragma unroll
            for (int m = 0; m < 4; ++m) { const int row = row0 + ai * 128 + m * 16;
#pragma unroll
                for (int bj = 0; bj < 2; ++bj)
#pragma unroll
                    for (int n = 0; n < 2; ++n) { const int col = col0 + bj * 128 + n * 16;
                        const pg8::u32x2 gw = *(const pg8::u32x2*)(Z + (size_t)row * NIN + C_GA + col);
                        const pg8::f32x4 a = acc[ai][bj][m][n]; pg8::f32x4 o;
                        o[0] = pg8::sigmoidf_(pg8::bf_lo(gw.x)) * a[0]; o[1] = pg8::sigmoidf_(pg8::bf_hi(gw.x)) * a[1];
                        o[2] = pg8::sigmoidf_(pg8::bf_lo(gw.y)) * a[2]; o[3] = pg8::sigmoidf_(pg8::bf_hi(gw.y)) * a[3];
                        *(pg8::f32x4*)(T1 + (size_t)row * DM + col) = o; } }
    }
};
struct EpiGateR {
    static constexpr bool PERM = true;
    const bf16* Z; const float* T1; bf16* MB;
    __device__ __forceinline__ void operator()(const pg8::f32x4 (&acc)[2][2][4][2], const pg8::Unit& u, int wr, int wc, int fr, int fq) const {
        const int row0 = u.pm * 256 + wr * 64 + fr, col0 = u.pn * 256 + wc * 32 + 8 * fq;
#pragma unroll
        for (int ai = 0; ai < 2; ++ai)
#pragma unroll
            for (int m = 0; m < 4; ++m) { const int row = row0 + ai * 128 + m * 16;
#pragma unroll
                for (int bj = 0; bj < 2; ++bj) { const int col = col0 + bj * 128;
                    const pg8::u32x4 gw = *(const pg8::u32x4*)(Z + (size_t)row * NIN + C_GRT + col);
                    const pg8::f32x4 t0 = *(const pg8::f32x4*)(T1 + (size_t)row * DM + col), t1 = *(const pg8::f32x4*)(T1 + (size_t)row * DM + col + 4);
                    const pg8::f32x4 a0 = acc[ai][bj][m][0], a1 = acc[ai][bj][m][1];
                    float o[8];
                    o[0] = t0[0] + pg8::sigmoidf_(pg8::bf_lo(gw.x)) * a0[0]; o[1] = t0[1] + pg8::sigmoidf_(pg8::bf_hi(gw.x)) * a0[1];
                    o[2] = t0[2] + pg8::sigmoidf_(pg8::bf_lo(gw.y)) * a0[2]; o[3] = t0[3] + pg8::sigmoidf_(pg8::bf_hi(gw.y)) * a0[3];
                    o[4] = t1[0] + pg8::sigmoidf_(pg8::bf_lo(gw.z)) * a1[0]; o[5] = t1[1] + pg8::sigmoidf_(pg8::bf_hi(gw.z)) * a1[1];
                    o[6] = t1[2] + pg8::sigmoidf_(pg8::bf_lo(gw.w)) * a1[2]; o[7] = t1[3] + pg8::sigmoidf_(pg8::bf_hi(gw.w)) * a1[3];
                    pg8::u32x4 w; w.x = pg8::cvt_pk_bf16(o[0], o[1]); w.y = pg8::cvt_pk_bf16(o[2], o[3]); w.z = pg8::cvt_pk_bf16(o[4], o[5]); w.w = pg8::cvt_pk_bf16(o[6], o[7]);
                    *(pg8::u32x4*)(MB + (size_t)row * DM + col) = w; } }
    }
};
struct EpiF32 {
    static constexpr bool PERM = false;
    float* C; int ldc;
    __device__ __forceinline__ void operator()(const pg8::f32x4 (&acc)[2][2][4][2], const pg8::Unit& u, int wr, int wc, int fr, int fq) const {
        const int row0 = u.pm * 256 + wr * 64 + fr, col0 = u.pn * 256 + wc * 32 + 4 * fq;
#pragma unroll
        for (int ai = 0; ai < 2; ++ai)
#pragma unroll
            for (int m = 0; m < 4; ++m) { float* rp = C + (size_t)(row0 + ai * 128 + m * 16) * ldc + col0;
#pragma unroll
                for (int bj = 0; bj < 2; ++bj)
#pragma unroll
                    for (int n = 0; n < 2; ++n) *(pg8::f32x4*)(rp + bj * 128 + n * 16) = acc[ai][bj][m][n]; }
    }
};
struct EpiRelu2 {
    static constexpr bool PERM = true;
    bf16* C; int ldc;
    __device__ __forceinline__ void operator()(const pg8::f32x4 (&acc)[2][2][4][2], const pg8::Unit& u, int wr, int wc, int fr, int fq) const {
        const int row0 = u.pm * 256 + wr * 64 + fr, col0 = u.pn * 256 + wc * 32 + 8 * fq;
#pragma unroll
        for (int ai = 0; ai < 2; ++ai)
#pragma unroll
            for (int m = 0; m < 4; ++m) { bf16* rp = C + (size_t)(row0 + ai * 128 + m * 16) * ldc + col0;
#pragma unroll
                for (int bj = 0; bj < 2; ++bj) { pg8::f32x4 v0 = acc[ai][bj][m][0], v1 = acc[ai][bj][m][1];
#pragma unroll
                    for (int e = 0; e < 4; ++e) { const float a = fmaxf(v0[e], 0.f), b = fmaxf(v1[e], 0.f); v0[e] = a * a; v1[e] = b * b; }
                    pg8::u32x4 w; w.x = pg8::cvt_pk_bf16(v0[0], v0[1]); w.y = pg8::cvt_pk_bf16(v0[2], v0[3]); w.z = pg8::cvt_pk_bf16(v1[0], v1[1]); w.w = pg8::cvt_pk_bf16(v1[2], v1[3]);
                    *(pg8::u32x4*)(rp + bj * 128) = w; } }
    }
};

__device__ __forceinline__ void p0_transpose_item(const float* W, int K, int N, bf16* WT, int ldk, int koff, LAS float* scr, int item, int lane) {
    const int nblk = N / 32, kb = item / nblk, nb = item % nblk, k0 = 64 * kb, n0 = 32 * nb;
#pragma unroll 8
    for (int i = 0; i < 32; ++i) { const int kk = 2 * i + (lane >> 5); scr[kk * 33 + (lane & 31)] = W[(size_t)(k0 + kk) * N + n0 + (lane & 31)]; }
    LDS_WAIT(); asm volatile("" ::: "memory");
    const int c = lane & 7;
#pragma unroll
    for (int j = 0; j < 4; ++j) { const int n = (lane >> 3) + 8 * j; const LAS float* s = scr + (8 * c) * 33 + n;
        v4u o; o.x = pk2(s[0 * 33], s[1 * 33]); o.y = pk2(s[2 * 33], s[3 * 33]); o.z = pk2(s[4 * 33], s[5 * 33]); o.w = pk2(s[6 * 33], s[7 * 33]);
        *(GAS v4u*)(WT + (size_t)(n0 + n) * ldk + koff + k0 + 8 * c) = o; }
    LDS_WAIT(); asm volatile("" ::: "memory");
}
__device__ __forceinline__ void rms_row_to_bf16(const float* xrow, const float* gain, bf16* orow, int lane) {
    const f32x4* xr = (const f32x4*)xrow + lane; const f32x4* gr = (const f32x4*)gain + lane;
    f32x4 v[4]; float s = 0.f;
#pragma unroll
    for (int j = 0; j < 4; ++j) { v[j] = xr[64 * j]; s += (v[j].x * v[j].x + v[j].y * v[j].y) + (v[j].z * v[j].z + v[j].w * v[j].w); }
    const float rstd = 1.0f / sqrtf(wave_sum(s) * (1.f / DM) + EPS);
    unsigned long long* o8 = (unsigned long long*)orow + lane;
#pragma unroll
    for (int j = 0; j < 4; ++j) { const f32x4 gg = gr[64 * j];
        o8[64 * j] = (unsigned long long)pk2(v[j].x * rstd * gg.x, v[j].y * rstd * gg.y) | ((unsigned long long)pk2(v[j].z * rstd * gg.z, v[j].w * rstd * gg.w) << 32); }
}
__device__ __forceinline__ void p0_prologue(Frame& F) {
    LAS float* scr = (LAS float*)(F.lds + F.wave * 16384);
    const int gw = F.vcu * NWAVES + F.wave, NGW = F.G * NWAVES;
    constexpr int I_IN = (DM / 64) * (NIN / 32), I_ATT = (512 / 64) * (DM / 32), I_RET = (DM / 64) * (DM / 32), I_OUT = I_RET, I_UP = (DM / 64) * (FF / 32), I_DN = (FF / 64) * (DM / 32);
    constexpr int NITEMS = I_IN + I_ATT + I_RET + I_OUT + I_UP + I_DN;
    for (int it = gw; it < NITEMS; it += NGW) {
        int r = it;
        if (r < I_IN) { p0_transpose_item(F.w_in, DM, NIN, F.WIN, DM, 0, scr, r, F.lane); continue; } r -= I_IN;
        if (r < I_ATT) { p0_transpose_item(F.w_att, 512, DM, F.WBR, KBR, 0, scr, r, F.lane); continue; } r -= I_ATT;
        if (r < I_RET) { p0_transpose_item(F.w_ret, DM, DM, F.WBR, KBR, 512, scr, r, F.lane); continue; } r -= I_RET;
        if (r < I_OUT) { p0_transpose_item(F.w_out, DM, DM, F.WOUT, DM, 0, scr, r, F.lane); continue; } r -= I_OUT;
        if (r < I_UP) { p0_transpose_item(F.w_up, DM, FF, F.WUP, DM, 0, scr, r, F.lane); continue; } r -= I_UP;
        p0_transpose_item(F.w_dn, FF, DM, F.WDN, FF, 0, scr, r, F.lane);
    }
    for (int m = gw; m < MPAD; m += NGW) {
        if (m < MREAL) rms_row_to_bf16(xrow_ptr(F, m), F.g_pre_mix, F.XN + (size_t)m * DM, F.lane);
        else { v4u z = {0u, 0u, 0u, 0u}; v4u* o = (v4u*)(F.XN + (size_t)m * DM) + F.lane; o[0] = z; o[64] = z; }
    }
    for (int e = (F.vcu * NWAVES + F.wave) * 64 + F.lane; e < 2049 * 64; e += NGW * 64) {
        const int p = e >> 6, i = e & 63; const double pos = (p == 2048) ? 8192.0 : (double)p;
        const double inv = exp2(-(double)i * (13.287712379549449 / 64.0));
        double sn, cs; sincos(pos * inv, &sn, &cs);
        F.ROPE[2 * e] = (float)cs; F.ROPE[2 * e + 1] = (float)sn;
    }
}

__device__ __forceinline__ float dot128_bf16(const bf16* k, const LAS float* qs) {
    float s = 0.f;
#pragma unroll
    for (int c = 0; c < 16; ++c) { const v4u w = *(const v4u*)(k + 8 * c); const LAS f32x4* q4 = (const LAS f32x4*)(qs + 8 * c); const f32x4 qa = q4[0], qb = q4[1];
        s += pg8::bf_lo(w.x) * qa.x + pg8::bf_hi(w.x) * qa.y + pg8::bf_lo(w.y) * qa.z + pg8::bf_hi(w.y) * qa.w + pg8::bf_lo(w.z) * qb.x + pg8::bf_hi(w.z) * qb.y + pg8::bf_lo(w.w) * qb.z + pg8::bf_hi(w.w) * qb.w; }
    return s;
}
__device__ __forceinline__ float dot128_f32(const float* k, const LAS float* qs) {
    float s = 0.f;
#pragma unroll
    for (int c = 0; c < 32; ++c) { const f32x4 w = *(const f32x4*)(k + 4 * c); const f32x4 q = *(const LAS f32x4*)(qs + 4 * c); s += w.x * q.x + w.y * q.y + w.z * q.z + w.w * q.w; }
    return s;
}
__device__ __forceinline__ void attn_simple_task(const Frame& F, int r, int h, LAS float* qs, LAS float* ps) {
    const int lane = F.lane; const bool samp = r >= MP; const int b = samp ? r - MP : (r >> 11), t = samp ? 0 : (r & 2047);
    float o0[3], o1[3], lse[3];
#pragma unroll
    for (int g = 0; g < 3; ++g) {
        const int d = g == 0 ? 1 : (g == 1 ? 4 : 16), L = 128 * d;
        const float* cache = g == 0 ? F.c1 : (g == 1 ? F.c4 : F.c16);
        { const unsigned qq = *(const unsigned*)(F.Z + (size_t)r * NIN + C_QA + g * 512 + h * 128 + 2 * lane); qs[2 * lane] = pg8::bf_lo(qq); qs[2 * lane + 1] = pg8::bf_hi(qq); }
        LDS_WAIT(); asm volatile("" ::: "memory");
        const int nk = samp ? 129 : ((t / d) < 128 ? (t / d) : 128) + 1;
        float s[3];
#pragma unroll
        for (int jj = 0; jj < 3; ++jj) {
            const int j = jj < 2 ? lane + 64 * jj : 128; const bool valid = (jj < 2 || lane == 0) && j < nk;
            float v = -1e30f;
            if (valid) {
                if (!samp) v = dot128_bf16(F.Z + (size_t)(b * SEQ + t - j * d) * NIN + C_KA + g * 512 + h * 128, qs);
                else if (j == 0) v = dot128_bf16(F.Z + (size_t)r * NIN + C_KA + g * 512 + h * 128, qs);
                else v = dot128_f32(cache + ((size_t)b * L + (L - j * d)) * 1024 + h * 128, qs);
                v *= 0.08838834764831845f;
            }
            s[jj] = v;
        }
        const float mx = wave_max(fmaxf(fmaxf(s[0], s[1]), s[2]));
        float p[3], l = 0.f;
#pragma unroll
        for (int jj = 0; jj < 3; ++jj) { p[jj] = (s[jj] > -1e29f) ? __expf(s[jj] - mx) : 0.f; l += p[jj]; }
        l = wave_sum(l);
        ps[lane] = p[0]; ps[lane + 64] = p[1]; if (lane == 0) ps[128] = p[2];
        LDS_WAIT(); asm volatile("" ::: "memory");
        float a0 = 0.f, a1 = 0.f;
        if (!samp) {
            const bf16* vb = F.Z + (size_t)(b * SEQ + t) * NIN + C_VA + g * 512 + h * 128 + 2 * lane;
            for (int j = 0; j < nk; ++j) { const unsigned w = *(const unsigned*)(vb - (size_t)j * d * NIN); const float pj = ps[j]; a0 += pj * pg8::bf_lo(w); a1 += pj * pg8::bf_hi(w); }
        } else {
            { const unsigned w = *(const unsigned*)(F.Z + (size_t)r * NIN + C_VA + g * 512 + h * 128 + 2 * lane); const float pj = ps[0]; a0 += pj * pg8::bf_lo(w); a1 += pj * pg8::bf_hi(w); }
            for (int j = 1; j < 129; ++j) { const f32x2 w = *(const f32x2*)(cache + ((size_t)b * L + (L - j * d)) * 1024 + 512 + h * 128 + 2 * lane); const float pj = ps[j]; a0 += pj * w.x; a1 += pj * w.y; }
        }
        const float il = 1.0f / l;
        o0[g] = a0 * il; o1[g] = a1 * il; lse[g] = mx + __logf(l);
        LDS_WAIT(); asm volatile("" ::: "memory");
    }
    const float ml = fmaxf(fmaxf(lse[0], lse[1]), lse[2]);
    const float w0 = __expf(lse[0] - ml), w1 = __expf(lse[1] - ml), w2 = __expf(lse[2] - ml), iw = 1.0f / (w0 + w1 + w2);
    const float r0 = (w0 * o0[0] + w1 * o0[1] + w2 * o0[2]) * iw, r1 = (w0 * o1[0] + w1 * o1[1] + w2 * o1[2]) * iw;
    *(unsigned*)(F.ABR + (size_t)r * KBR + h * 128 + 2 * lane) = pk2(r0, r1);
}
__device__ __forceinline__ void ret_simple_task(const Frame& F, int b, int h, bool samp) {
    constexpr int TB = 16;
    LAS float* qk = (LAS float*)F.lds;
    LAS float* red = (LAS float*)(F.lds + 16384);
    const int tid = F.tid, dv = tid & 255, half = tid >> 8;
    const float gamma = 1.0f - exp2f(-5.0f - (float)h);
    float S[64];
    if (samp) {
#pragma unroll
        for (int i = 0; i < 64; ++i) S[i] = F.st0[((size_t)(b * 4 + h) * 128 + half * 64 + i) * 256 + dv];
    } else {
#pragma unroll
        for (int i = 0; i < 64; ++i) S[i] = 0.f;
    }
    const int T = samp ? 1 : SEQ, rowbase = samp ? MP + b : b * SEQ;
    for (int t0 = 0; t0 < T; t0 += TB) {
        const int nb = (T - t0) < TB ? (T - t0) : TB;
        __syncthreads();
        for (int idx = tid; idx < nb * 128; idx += 512) {
            const int tt = idx >> 7, i = idx & 127, which = i >> 6, ii = i & 63, row = rowbase + t0 + tt, pidx = samp ? 2048 : (t0 + tt);
            const bf16* src = F.Z + (size_t)row * NIN + (which ? C_KR : C_QR) + h * 128;
            const float x1 = bf2f(src[ii]), x2 = bf2f(src[ii + 64]);
            const f32x2 cs = *(const f32x2*)(F.ROPE + 2 * (pidx * 64 + ii));
            const float sc = which ? 0.08838834764831845f : 1.0f;
            qk[(tt * 2 + which) * 128 + ii] = (x1 * cs.x - x2 * cs.y) * sc; qk[(tt * 2 + which) * 128 + ii + 64] = (x1 * cs.y + x2 * cs.x) * sc;
        }
        __syncthreads();
        for (int tt = 0; tt < nb; ++tt) {
            const int row = rowbase + t0 + tt;
            const float v = bf2f(F.Z[(size_t)row * NIN + C_VR + h * 256 + dv]);
            const LAS f32x4* q4 = (const LAS f32x4*)(qk + (tt * 2 + 0) * 128 + half * 64); const LAS f32x4* k4 = (const LAS f32x4*)(qk + (tt * 2 + 1) * 128 + half * 64);
            float acc = 0.f;
#pragma unroll
            for (int c = 0; c < 16; ++c) { const f32x4 q = q4[c], k = k4[c];
                S[4 * c + 0] = gamma * S[4 * c + 0] + k.x * v; acc += q.x * S[4 * c + 0];
                S[4 * c + 1] = gamma * S[4 * c + 1] + k.y * v; acc += q.y * S[4 * c + 1];
                S[4 * c + 2] = gamma * S[4 * c + 2] + k.z * v; acc += q.z * S[4 * c + 2];
                S[4 * c + 3] = gamma * S[4 * c + 3] + k.w * v; acc += q.w * S[4 * c + 3]; }
            red[(tt * 2 + half) * 256 + dv] = acc;
        }
        __syncthreads();
        for (int idx = tid; idx < nb * 256; idx += 512) { const int tt = idx >> 8, c = idx & 255;
            F.RO[(size_t)(rowbase + t0 + tt) * DM + h * 256 + c] = red[(tt * 2 + 0) * 256 + c] + red[(tt * 2 + 1) * 256 + c]; }
    }
    float* so = F.out + (samp ? O_STS : O_STP);
#pragma unroll
    for (int i = 0; i < 64; ++i) so[((size_t)(b * 4 + h) * 128 + half * 64 + i) * 256 + dv] = S[i];
    __syncthreads();
}
__device__ __forceinline__ void gn_gate_task(const Frame& F, int r, int h) {
    const int lane = F.lane;
    const f32x4 x = *(const f32x4*)(F.RO + (size_t)r * DM + h * 256 + 4 * lane);
    const float mu = wave_sum((x.x + x.y) + (x.z + x.w)) * (1.f / 256.f);
    const f32x4 d = x - mu;
    const float var = wave_sum((d.x * d.x + d.y * d.y) + (d.z * d.z + d.w * d.w)) * (1.f / 256.f);
    const float rstd = 1.0f / sqrtf(var + EPS);
    const f32x4 gn = *(const f32x4*)(F.g_ret + h * 256 + 4 * lane);
    const v2u gw = *(const v2u*)(F.Z + (size_t)r * NIN + C_GR + h * 256 + 4 * lane);
    const float g0 = pg8::bf_lo(gw.x), g1 = pg8::bf_hi(gw.x), g2 = pg8::bf_lo(gw.y), g3 = pg8::bf_hi(gw.y);
    const float y0 = g0 * pg8::sigmoidf_(g0) * (d.x * rstd * gn.x), y1 = g1 * pg8::sigmoidf_(g1) * (d.y * rstd * gn.y);
    const float y2 = g2 * pg8::sigmoidf_(g2) * (d.z * rstd * gn.z), y3 = g3 * pg8::sigmoidf_(g3) * (d.w * rstd * gn.w);
    v2u o; o.x = pk2(y0, y1); o.y = pk2(y2, y3);
    *(v2u*)(F.ABR + (size_t)r * KBR + 512 + h * 256 + 4 * lane) = o;
}

typedef short bf16x8s __attribute__((ext_vector_type(8)));
typedef short s16x4 __attribute__((ext_vector_type(4)));
__device__ __forceinline__ unsigned off_b(unsigned row, unsigned ch) { return 256u * row + 16u * (ch ^ (((row & 3u) << 2) | ((row >> 2) & 3u))); }
__device__ __forceinline__ s16x4 tr_read16(const LAS unsigned char* p) { return __builtin_bit_cast(s16x4, __builtin_amdgcn_ds_read_tr16_b64_v4i16((LAS s16x4*)p)); }
#define MFMA16(a, b, c) __builtin_amdgcn_mfma_f32_16x16x32_bf16((a), (b), (c), 0, 0, 0)
struct AttnPre { v4u k[8], v[8]; bf16x8s q[4]; };
struct AttnUnit { int b, g, h, c, blk, d; };
__device__ __forceinline__ AttnUnit attn_decode(int uidx) {
    AttnUnit u; const int bgh = uidx >> 4, uu = uidx & 15; u.b = bgh / 12; const int gh = bgh % 12; u.g = gh >> 2; u.h = gh & 3;
    u.d = u.g == 0 ? 1 : (u.g == 1 ? 4 : 16); const int nb = 16 / u.d; u.c = uu / nb; u.blk = uu % nb; return u;
}
__device__ __forceinline__ void attn_prefetch(const Frame& F, const AttnUnit& u, AttnPre& P) {
    const bf16* zb = F.Z + (size_t)(u.b * SEQ) * NIN + u.g * 512 + u.h * 128;
#pragma unroll
    for (int i = 0; i < 8; ++i) {
        const int id = F.tid + 512 * i, row = id >> 4, ch = id & 15, ki = (u.blk - 1) * 128 + row;
        if (ki >= 0) { const bf16* src = zb + (size_t)(ki * u.d + u.c) * NIN + ch * 8; P.k[i] = *(const v4u*)(src + C_KA); P.v[i] = *(const v4u*)(src + C_VA); }
        else { P.k[i] = (v4u){0u, 0u, 0u, 0u}; P.v[i] = (v4u){0u, 0u, 0u, 0u}; }
    }
    const int qi = u.blk * 128 + 16 * F.wave + (F.lane & 15);
    const bf16* qsrc = zb + (size_t)(qi * u.d + u.c) * NIN + C_QA + 8 * (F.lane >> 4);
#pragma unroll
    for (int ks = 0; ks < 4; ++ks) P.q[ks] = *(const bf16x8s*)(qsrc + 32 * ks);
}
__device__ __forceinline__ void attn_stage(const Frame& F, const AttnPre& P) {
    LAS unsigned char* Kt = F.lds; LAS unsigned char* Vt = F.lds + 256 * RS;
#pragma unroll
    for (int i = 0; i < 8; ++i) { const int id = F.tid + 512 * i, row = id >> 4, ch = id & 15; const unsigned o = (unsigned)(RS * row + 16 * ch);
        *(LAS v4u*)(Kt + o) = P.k[i]; *(LAS v4u*)(Vt + o) = P.v[i]; }
}
__device__ __forceinline__ void attn_compute(const Frame& F, const AttnUnit& u, const bf16x8s (&qf)[4]) {
    const int lane = F.lane, w = F.wave, m = lane & 15, kg = lane >> 4;
    const int start = w < 6 ? w : 6, kbase = 16 * start;
    const int qq = m >> 2, pp = lane & 3;
    const LAS unsigned char* kb = F.lds + RS * (kbase + 8 * (m >> 2) + (m & 3)) + 16 * kg;
    const LAS unsigned char* vb = F.lds + 256 * RS + RS * (kbase + 8 * kg + qq) + 8 * pp;
    f32x4 sacc[5][2];
#pragma unroll
    for (int s = 0; s < 5; ++s)
#pragma unroll
        for (int t = 0; t < 2; ++t) {
            f32x4 a = {0.f, 0.f, 0.f, 0.f};
#pragma unroll
            for (int ks = 0; ks < 4; ++ks) { const bf16x8s kf = *(const LAS bf16x8s*)(kb + RS * (32 * s + 4 * t) + 64 * ks); a = MFMA16(kf, qf[ks], a); }
            sacc[s][t] = a; __builtin_amdgcn_sched_barrier(0);
        }
    const int qi = 16 * w + m; const float sc = 0.08838834764831845f * 1.4426950408889634f;
    float mx = -1e30f;
#pragma unroll
    for (int s = 0; s < 5; ++s)
#pragma unroll
        for (int t = 0; t < 2; ++t)
#pragma unroll
            for (int e = 0; e < 4; ++e) { const int kj = kbase + 32 * s + 8 * kg + 4 * t + e; const bool ok = (kj >= qi) && (kj <= qi + 128) && (u.blk > 0 || kj >= 128);
                const float v = ok ? sacc[s][t][e] * sc : -1e30f; sacc[s][t][e] = v; mx = fmaxf(mx, v); }
    mx = fmaxf(mx, __shfl_xor(mx, 16)); mx = fmaxf(mx, __shfl_xor(mx, 32));
    float l = 0.f;
#pragma unroll
    for (int s = 0; s < 5; ++s)
#pragma unroll
        for (int t = 0; t < 2; ++t)
#pragma unroll
            for (int e = 0; e < 4; ++e) { const float p = __builtin_amdgcn_exp2f(sacc[s][t][e] - mx); sacc[s][t][e] = p; l += p; }
    l += __shfl_xor(l, 16); l += __shfl_xor(l, 32);
    bf16x8s pf[5];
#pragma unroll
    for (int s = 0; s < 5; ++s) { v4u pw; pw.x = pg8::cvt_pk_bf16(sacc[s][0][0], sacc[s][0][1]); pw.y = pg8::cvt_pk_bf16(sacc[s][0][2], sacc[s][0][3]);
        pw.z = pg8::cvt_pk_bf16(sacc[s][1][0], sacc[s][1][1]); pw.w = pg8::cvt_pk_bf16(sacc[s][1][2], sacc[s][1][3]); pf[s] = __builtin_bit_cast(bf16x8s, pw); }
    __builtin_amdgcn_sched_barrier(0);
    const float il = 1.0f / l;
    const int qpos = (u.blk * 128 + qi) * u.d + u.c; const size_t orow = (size_t)(u.b * SEQ + qpos);
    bf16* op = F.OG + ((size_t)u.g * MPAD + orow) * 512 + u.h * 128 + 4 * kg;
#pragma unroll
    for (int dvt = 0; dvt < 8; ++dvt) {
        f32x4 o = {0.f, 0.f, 0.f, 0.f};
#pragma unroll
        for (int s = 0; s < 5; ++s) {
            const s16x4 lo = tr_read16(vb + RS * (32 * s) + 32 * dvt);
            const s16x4 hi = tr_read16(vb + RS * (32 * s + 4) + 32 * dvt);
            const bf16x8s vf = __builtin_shufflevector(lo, hi, 0, 1, 2, 3, 4, 5, 6, 7);
            o = MFMA16(vf, pf[s], o);
        }
        v2u ow; ow.x = pg8::cvt_pk_bf16(o[0] * il, o[1] * il); ow.y = pg8::cvt_pk_bf16(o[2] * il, o[3] * il);
        *(v2u*)(op + 16 * dvt) = ow; __builtin_amdgcn_sched_barrier(0);
    }
    if (kg == 0) F.LSE[((size_t)u.g * MPAD + orow) * 4 + u.h] = (mx + __builtin_amdgcn_logf(l)) * 0.6931471805599453f;
}
__device__ __forceinline__ void attn_mfma_phase(const Frame& F, int rank, int nrank) {
    constexpr int NU = NB * 12 * 16;
    if (rank < 0 || rank >= NU) return;
    AttnPre P; AttnUnit u = attn_decode(rank);
    attn_prefetch(F, u, P);
    for (int uidx = rank; uidx < NU; uidx += nrank) {
        __syncthreads();
        attn_stage(F, P);
        bf16x8s qf[4];
#pragma unroll
        for (int ks = 0; ks < 4; ++ks) qf[ks] = P.q[ks];
        __syncthreads();
        const AttnUnit cur = u;
        if (uidx + nrank < NU) { u = attn_decode(uidx + nrank); attn_prefetch(F, u, P); }
        attn_compute(F, cur, qf);
    }
    __syncthreads();
}
__device__ __forceinline__ void attn_combine_row(const Frame& F, int r) {
    const int lane = F.lane, h = lane >> 4;
    float ls[3]; v4u og[3];
#pragma unroll
    for (int g = 0; g < 3; ++g) { ls[g] = F.LSE[((size_t)g * MPAD + r) * 4 + h]; og[g] = *(const v4u*)(F.OG + ((size_t)g * MPAD + r) * 512 + 8 * lane); }
    const float ml = fmaxf(fmaxf(ls[0], ls[1]), ls[2]);
    const float w0 = __expf(ls[0] - ml), w1 = __expf(ls[1] - ml), w2 = __expf(ls[2] - ml), iw = 1.0f / (w0 + w1 + w2);
    const float a0 = w0 * iw, a1 = w1 * iw, a2 = w2 * iw;
    v4u o;
#define CMB(f) pk2(a0 * pg8::bf_lo(og[0].f) + a1 * pg8::bf_lo(og[1].f) + a2 * pg8::bf_lo(og[2].f), a0 * pg8::bf_hi(og[0].f) + a1 * pg8::bf_hi(og[1].f) + a2 * pg8::bf_hi(og[2].f))
    o.x = CMB(x); o.y = CMB(y); o.z = CMB(z); o.w = CMB(w);
#undef CMB
    *(v4u*)(F.ABR + (size_t)r * KBR + 8 * lane) = o;
}

__device__ __forceinline__ void unpack8(const v4u x, float (&a)[8]) { a[0] = pg8::bf_lo(x.x); a[1] = pg8::bf_hi(x.x); a[2] = pg8::bf_lo(x.y); a[3] = pg8::bf_hi(x.y); a[4] = pg8::bf_lo(x.z); a[5] = pg8::bf_hi(x.z); a[6] = pg8::bf_lo(x.w); a[7] = pg8::bf_hi(x.w); }
__device__ __forceinline__ v4u pack8(const float (&a)[8]) { v4u o; o.x = pg8::cvt_pk_bf16(a[0], a[1]); o.y = pg8::cvt_pk_bf16(a[2], a[3]); o.z = pg8::cvt_pk_bf16(a[4], a[5]); o.w = pg8::cvt_pk_bf16(a[6], a[7]); return o; }
__device__ __forceinline__ void ret_stage_k(const Frame& F, int b, int h, int c, bool with_tail, float l2g, LAS unsigned char* Kt) {
#pragma unroll
    for (int i = 0; i < 2; ++i) {
        const int id = F.tid + 512 * i, tok = id >> 3, c2 = id & 7, t = c * 128 + tok;
        const bf16* src = F.Z + (size_t)(b * SEQ + t) * NIN + C_KR + h * 128 + 8 * c2;
        const v4u x1 = *(const v4u*)src, x2 = *(const v4u*)(src + 64);
        const f32x4* rp = (const f32x4*)(F.ROPE + 2 * (t * 64 + 8 * c2));
        const f32x4 r0 = rp[0], r1 = rp[1], r2 = rp[2], r3 = rp[3];
        const float cs[8] = {r0.x, r0.z, r1.x, r1.z, r2.x, r2.z, r3.x, r3.z}, sn[8] = {r0.y, r0.w, r1.y, r1.w, r2.y, r2.w, r3.y, r3.w};
        const float f = 0.08838834764831845f * (with_tail ? __builtin_amdgcn_exp2f((float)(127 - tok) * l2g) : 1.0f);
        float a[8], bb[8], o1[8], o2[8]; unpack8(x1, a); unpack8(x2, bb);
#pragma unroll
        for (int j = 0; j < 8; ++j) { o1[j] = (a[j] * cs[j] - bb[j] * sn[j]) * f; o2[j] = (a[j] * sn[j] + bb[j] * cs[j]) * f; }
        *(LAS v4u*)(Kt + RS * tok + 16 * c2) = pack8(o1); *(LAS v4u*)(Kt + RS * tok + 128 + 16 * c2) = pack8(o2);
    }
}
__device__ __forceinline__ void ret_stage_v(const Frame& F, int b, int h, int c, LAS unsigned char* Vt) {
#pragma unroll
    for (int i = 0; i < 8; ++i) {
        const int id = F.tid + 512 * i, tok = id >> 5, ch = id & 31;
        const v4u x = *(const v4u*)(F.Z + (size_t)(b * SEQ + c * 128 + tok) * NIN + C_VR + h * 256 + 8 * ch);
        *(LAS v4u*)(Vt + VS * tok + 16 * ch) = x;
    }
}
template <int STRIDE> __device__ __forceinline__ bf16x8s tr_frag(const LAS unsigned char* base, int s, int colb) {
    const s16x4 lo = tr_read16(base + STRIDE * (32 * s) + colb);
    const s16x4 hi = tr_read16(base + STRIDE * (32 * s + 4) + colb);
    return __builtin_shufflevector(lo, hi, 0, 1, 2, 3, 4, 5, 6, 7);
}
__device__ __forceinline__ void ret_stepA(const Frame& F, int b, int h, int c) {
    LAS unsigned char* Vt = F.lds; LAS unsigned char* Kt = F.lds + 256 * RS;
    const int lane = F.lane, w = F.wave, m = lane & 15, kg = lane >> 4, qq = m >> 2, pp = lane & 3;
    const float l2g = __builtin_amdgcn_logf(1.0f - __builtin_amdgcn_exp2f(-5.0f - (float)h));
    const LAS unsigned char* ktb = Kt + RS * (8 * kg + qq) + 8 * pp; const LAS unsigned char* vtb = Vt + VS * (8 * kg + qq) + 8 * pp;
    __syncthreads();
    ret_stage_k(F, b, h, c, true, l2g, Kt); ret_stage_v(F, b, h, c, Vt);
    __syncthreads();
    f32x4 acc[8][2];
#pragma unroll
    for (int i = 0; i < 8; ++i) { acc[i][0] = (f32x4){0.f, 0.f, 0.f, 0.f}; acc[i][1] = (f32x4){0.f, 0.f, 0.f, 0.f}; }
#pragma unroll
    for (int s = 0; s < 4; ++s) {
        bf16x8s vf[2];
#pragma unroll
        for (int j2 = 0; j2 < 2; ++j2) vf[j2] = tr_frag<VS>(vtb + 64 * w, s, 32 * j2);
#pragma unroll
        for (int i = 0; i < 8; ++i) { const bf16x8s kf = tr_frag<RS>(ktb, s, 32 * i); acc[i][0] = MFMA16(kf, vf[0], acc[i][0]); acc[i][1] = MFMA16(kf, vf[1], acc[i][1]); if (i & 1) __builtin_amdgcn_sched_barrier(0); }
    }
    bf16* ut = F.UT + ((size_t)((b * 4 + h) * 16 + c)) * 32768;
#pragma unroll
    for (int j2 = 0; j2 < 2; ++j2)
#pragma unroll
        for (int i = 0; i < 8; ++i) { v2u o; o.x = pg8::cvt_pk_bf16(acc[i][j2][0], acc[i][j2][1]); o.y = pg8::cvt_pk_bf16(acc[i][j2][2], acc[i][j2][3]);
            *(v2u*)(ut + (size_t)(16 * (2 * w + j2) + m) * 128 + 16 * i + 4 * kg) = o; }
}
__device__ __forceinline__ void ret_stepB(const Frame& F, int b, int h, int c) {
    LAS unsigned char* St = F.lds; LAS unsigned char* Kt = F.lds + 256 * RS;
    const int lane = F.lane, w = F.wave, m = lane & 15, kg = lane >> 4, qq = m >> 2, pp = lane & 3;
    const LAS unsigned char* stb = St + RS * m + 16 * kg; const LAS unsigned char* krb = Kt + RS * (8 * (m >> 2) + (m & 3)) + 16 * kg; const LAS unsigned char* vtb = St + VS * (8 * kg + qq) + 8 * pp;
    const float l2g = __builtin_amdgcn_logf(1.0f - __builtin_amdgcn_exp2f(-5.0f - (float)h));
    const float g128 = __builtin_amdgcn_exp2f(128.0f * l2g);
    const int q = 16 * w + m, t = c * 128 + q; const size_t row = (size_t)(b * SEQ + t);
    __syncthreads();
    {
        const bf16* ut = F.UT + ((size_t)((b * 4 + h) * 16)) * 32768 + (size_t)F.tid * 8;
        float S[8][8];
#pragma unroll
        for (int i = 0; i < 8; ++i)
#pragma unroll
            for (int e = 0; e < 8; ++e) S[i][e] = 0.f;
#pragma unroll 1
        for (int j = 0; j < c; ++j) {
            v4u u[8];
#pragma unroll
            for (int i = 0; i < 8; ++i) u[i] = *(const v4u*)(ut + (size_t)j * 32768 + 4096 * i);
#pragma unroll
            for (int i = 0; i < 8; ++i) { float x[8]; unpack8(u[i], x);
#pragma unroll
                for (int e = 0; e < 8; ++e) S[i][e] = g128 * S[i][e] + x[e]; }
        }
#pragma unroll
        for (int i = 0; i < 8; ++i) { const int id = F.tid + 512 * i; *(LAS v4u*)(St + RS * (id >> 4) + 16 * (id & 15)) = pack8(S[i]); }
    }
    bf16x8s qf[4], qf2[4];
    {
        const bf16* qsrc = F.Z + row * NIN + C_QR + h * 128 + 8 * kg;
        const float inner = __builtin_amdgcn_exp2f((float)(q + 1) * l2g);
#pragma unroll
        for (int ks = 0; ks < 2; ++ks) {
            const v4u x1 = *(const v4u*)(qsrc + 32 * ks), x2 = *(const v4u*)(qsrc + 32 * ks + 64);
            const f32x4* rp = (const f32x4*)(F.ROPE + 2 * (t * 64 + 32 * ks + 8 * kg));
            const f32x4 r0 = rp[0], r1 = rp[1], r2 = rp[2], r3 = rp[3];
            const float cs[8] = {r0.x, r0.z, r1.x, r1.z, r2.x, r2.z, r3.x, r3.z}, sn[8] = {r0.y, r0.w, r1.y, r1.w, r2.y, r2.w, r3.y, r3.w};
            float a[8], bb[8], o1[8], o2[8], p1[8], p2[8]; unpack8(x1, a); unpack8(x2, bb);
#pragma unroll
            for (int j = 0; j < 8; ++j) { o1[j] = a[j] * cs[j] - bb[j] * sn[j]; o2[j] = a[j] * sn[j] + bb[j] * cs[j]; p1[j] = o1[j] * inner; p2[j] = o2[j] * inner; }
            qf[ks] = __builtin_bit_cast(bf16x8s, pack8(o1)); qf[ks + 2] = __builtin_bit_cast(bf16x8s, pack8(o2));
            qf2[ks] = __builtin_bit_cast(bf16x8s, pack8(p1)); qf2[ks + 2] = __builtin_bit_cast(bf16x8s, pack8(p2));
        }
    }
    f32x4 acc[16];
#pragma unroll
    for (int i = 0; i < 16; ++i) acc[i] = (f32x4){0.f, 0.f, 0.f, 0.f};
    __syncthreads();
    if (c > 0) {
#pragma unroll
        for (int dvt = 0; dvt < 16; ++dvt)
#pragma unroll
            for (int ks = 0; ks < 4; ++ks) { const bf16x8s sf = *(const LAS bf16x8s*)(stb + RS * 16 * dvt + 64 * ks); acc[dvt] = MFMA16(sf, qf2[ks], acc[dvt]); if (ks == 3 && (dvt & 1)) __builtin_amdgcn_sched_barrier(0); }
    }
    __syncthreads();
    ret_stage_k(F, b, h, c, false, l2g, Kt); ret_stage_v(F, b, h, c, St);
    __syncthreads();
    const int ns = (w >> 1) + 1;
    float gneg[8];
#pragma unroll
    for (int j = 0; j < 8; ++j) gneg[j] = __builtin_amdgcn_exp2f(-(float)j * l2g);
#pragma unroll
    for (int s = 0; s < 4; ++s) {
        if (s < ns) {
            f32x4 p[2];
#pragma unroll
            for (int t2 = 0; t2 < 2; ++t2) { f32x4 a = {0.f, 0.f, 0.f, 0.f};
#pragma unroll
                for (int ks = 0; ks < 4; ++ks) { const bf16x8s kf = *(const LAS bf16x8s*)(krb + RS * (32 * s + 4 * t2) + 64 * ks); a = MFMA16(kf, qf[ks], a); }
                p[t2] = a; }
            {
                const int d0 = q - 32 * s - 8 * kg; const float bs = __builtin_amdgcn_exp2f((float)d0 * l2g);
#pragma unroll
                for (int t2 = 0; t2 < 2; ++t2)
#pragma unroll
                    for (int e = 0; e < 4; ++e) p[t2][e] = (d0 >= 4 * t2 + e) ? p[t2][e] * (bs * gneg[4 * t2 + e]) : 0.f;
            }
            v4u pw; pw.x = pg8::cvt_pk_bf16(p[0][0], p[0][1]); pw.y = pg8::cvt_pk_bf16(p[0][2], p[0][3]); pw.z = pg8::cvt_pk_bf16(p[1][0], p[1][1]); pw.w = pg8::cvt_pk_bf16(p[1][2], p[1][3]);
            const bf16x8s pf = __builtin_bit_cast(bf16x8s, pw); __builtin_amdgcn_sched_barrier(0);
#pragma unroll
            for (int dvt = 0; dvt < 16; ++dvt) { const bf16x8s vf = tr_frag<VS>(vtb, s, 32 * dvt); acc[dvt] = MFMA16(vf, pf, acc[dvt]); if (dvt & 1) __builtin_amdgcn_sched_barrier(0); }
        }
    }
    float sm = 0.f;
#pragma unroll
    for (int i = 0; i < 16; ++i) sm += (acc[i][0] + acc[i][1]) + (acc[i][2] + acc[i][3]);
    sm += __shfl_xor(sm, 16); sm += __shfl_xor(sm, 32);
    const float mu = sm * (1.f / 256.f); float vs = 0.f;
#pragma unroll
    for (int i = 0; i < 16; ++i) { acc[i] = acc[i] - mu; vs += (acc[i][0] * acc[i][0] + acc[i][1] * acc[i][1]) + (acc[i][2] * acc[i][2] + acc[i][3] * acc[i][3]); }
    vs += __shfl_xor(vs, 16); vs += __shfl_xor(vs, 32);
    const float rstd = 1.0f / sqrtf(vs * (1.f / 256.f) + EPS);
    const bf16* gsrc = F.Z + row * NIN + C_GR + h * 256 + 4 * kg; const float* gn = F.g_ret + h * 256 + 4 * kg;
    bf16* dst = F.ABR + row * KBR + 512 + h * 256 + 4 * kg;
#pragma unroll
    for (int i = 0; i < 16; ++i) {
        const v2u gw = *(const v2u*)(gsrc + 16 * i); const f32x4 g4 = *(const f32x4*)(gn + 16 * i);
        const float g0 = pg8::bf_lo(gw.x), g1 = pg8::bf_hi(gw.x), g2 = pg8::bf_lo(gw.y), g3 = pg8::bf_hi(gw.y);
        v2u o; o.x = pg8::cvt_pk_bf16(g0 * pg8::sigmoidf_(g0) * (acc[i][0] * rstd * g4.x), g1 * pg8::sigmoidf_(g1) * (acc[i][1] * rstd * g4.y));
        o.y = pg8::cvt_pk_bf16(g2 * pg8::sigmoidf_(g2) * (acc[i][2] * rstd * g4.z), g3 * pg8::sigmoidf_(g3) * (acc[i][3] * rstd * g4.w));
        *(v2u*)(dst + 16 * i) = o;
    }
}

__device__ __forceinline__ void ret_final_state(const Frame& F) {
    for (int gid = (int)blockIdx.x * 512 + F.tid; gid < 32 * 4096; gid += F.G * 512) {
        const int bh = gid >> 12, chunk = gid & 4095, dv = chunk >> 4, dk0 = 8 * (chunk & 15), h = bh & 3;
        const float l2g = __builtin_amdgcn_logf(1.0f - __builtin_amdgcn_exp2f(-5.0f - (float)h)), g128 = __builtin_amdgcn_exp2f(128.0f * l2g);
        const bf16* ut = F.UT + (size_t)bh * 16 * 32768 + (size_t)chunk * 8;
        float S[8];
#pragma unroll
        for (int e = 0; e < 8; ++e) S[e] = 0.f;
#pragma unroll
        for (int j = 0; j < 16; ++j) { const v4u u = *(const v4u*)(ut + (size_t)j * 32768); float x[8]; unpack8(u, x);
#pragma unroll
            for (int e = 0; e < 8; ++e) S[e] = g128 * S[e] + x[e]; }
        float* so = F.out + O_STP + (size_t)bh * 32768 + (size_t)dk0 * 256 + dv;
#pragma unroll
        for (int e = 0; e < 8; ++e) so[e * 256] = S[e];
    }
}

__device__ __forceinline__ void mix_norm_row(const Frame& F, int r) {
    const int lane = F.lane;
    const f32x4* orow = (const f32x4*)(F.O + (size_t)r * DM) + lane; const f32x4* xr = (const f32x4*)xrow_ptr(F, r) + lane;
    const f32x4* g1 = (const f32x4*)F.g_post_mix + lane; const f32x4* g2 = (const f32x4*)F.g_pre_mlp + lane;
    f32x4 o[4], x[4]; float s = 0.f;
#pragma unroll
    for (int j = 0; j < 4; ++j) { o[j] = orow[64 * j]; x[j] = xr[64 * j]; s += (o[j].x * o[j].x + o[j].y * o[j].y) + (o[j].z * o[j].z + o[j].w * o[j].w); }
    const float rstd = 1.0f / sqrtf(wave_sum(s) * (1.f / DM) + EPS);
    float s2 = 0.f;
#pragma unroll
    for (int j = 0; j < 4; ++j) { x[j] = x[j] + o[j] * rstd * g1[64 * j]; s2 += (x[j].x * x[j].x + x[j].y * x[j].y) + (x[j].z * x[j].z + x[j].w * x[j].w); }
    const float rstd2 = 1.0f / sqrtf(wave_sum(s2) * (1.f / DM) + EPS);
    f32x4* yr = (f32x4*)(F.out + O_Y + (size_t)r * DM) + lane;
    unsigned long long* o8 = (unsigned long long*)(F.XN2 + (size_t)r * DM) + lane;
#pragma unroll
    for (int j = 0; j < 4; ++j) { yr[64 * j] = x[j]; const f32x4 gg = g2[64 * j];
        o8[64 * j] = (unsigned long long)pk2(x[j].x * rstd2 * gg.x, x[j].y * rstd2 * gg.y) | ((unsigned long long)pk2(x[j].z * rstd2 * gg.z, x[j].w * rstd2 * gg.w) << 32); }
}
__device__ __forceinline__ void mlp_norm_row(const Frame& F, int r) {
    const int lane = F.lane;
    const f32x4* drow = (const f32x4*)(F.DN + (size_t)r * DM) + lane; f32x4* yr = (f32x4*)(F.out + O_Y + (size_t)r * DM) + lane; const f32x4* g3 = (const f32x4*)F.g_post_mlp + lane;
    f32x4 d[4]; float s = 0.f;
#pragma unroll
    for (int j = 0; j < 4; ++j) { d[j] = drow[64 * j]; s += (d[j].x * d[j].x + d[j].y * d[j].y) + (d[j].z * d[j].z + d[j].w * d[j].w); }
    const float rstd = 1.0f / sqrtf(wave_sum(s) * (1.f / DM) + EPS);
#pragma unroll
    for (int j = 0; j < 4; ++j) yr[64 * j] = yr[64 * j] + d[j] * rstd * g3[64 * j];
}

constexpr int N_PHASES = 11;
struct Args { const float* in[17]; float* out; unsigned char* ws; int ph_lo, ph_hi; };
__global__ void __launch_bounds__(NWAVES * 64, 2) fwd_kernel(Args args) {
    extern __shared__ __attribute__((aligned(16))) unsigned char lds[];
    Frame F;
    F.lds = (LAS unsigned char*)lds;
    volatile LAS unsigned* MISC = (volatile LAS unsigned*)(F.lds + MISC_OFF);
    F.tid = threadIdx.x; F.lane = F.tid & 63; F.wave = __builtin_amdgcn_readfirstlane(F.tid >> 6);
    F.G = gridDim.x; { const int bx = blockIdx.x; F.vcu = (F.G % 8 == 0) ? (bx % 8) * (F.G / 8) + bx / 8 : bx; }
    unsigned char* ws = args.ws;
    F.xp = args.in[0]; F.xs = args.in[1]; F.c1 = args.in[2]; F.c4 = args.in[3]; F.c16 = args.in[4]; F.st0 = args.in[5];
    F.w_in = args.in[6]; F.w_att = args.in[7]; F.w_ret = args.in[8]; F.w_out = args.in[9]; F.w_up = args.in[10]; F.w_dn = args.in[11];
    F.g_ret = args.in[12]; F.g_pre_mix = args.in[13]; F.g_post_mix = args.in[14]; F.g_pre_mlp = args.in[15]; F.g_post_mlp = args.in[16];
    F.out = args.out;
    F.WIN = (bf16*)(ws + WS_WIN); F.WBR = (bf16*)(ws + WS_WBR); F.WOUT = (bf16*)(ws + WS_WOUT); F.WUP = (bf16*)(ws + WS_WUP); F.WDN = (bf16*)(ws + WS_WDN);
    F.ROPE = (float*)(ws + WS_ROPE); F.XN = (bf16*)(ws + WS_XN); F.Z = (bf16*)(ws + WS_Z); F.ABR = (bf16*)(ws + WS_ABR); F.RO = (float*)(ws + WS_RO);
    F.T1 = (float*)(ws + WS_T1); F.MB = (bf16*)(ws + WS_MB); F.O = (float*)(ws + WS_O); F.XN2 = (bf16*)(ws + WS_XN2); F.U = (bf16*)(ws + WS_U); F.DN = (float*)(ws + WS_DN); F.OG = (bf16*)(ws + WS_OG); F.LSE = (float*)(ws + WS_LSE); F.UT = (bf16*)(ws + WS_UT);
    for (int u = F.tid; u < (LDS_BYTES - LDSCTL_OFF) / 4; u += NWAVES * 64) ((LAS unsigned*)(F.lds + LDSCTL_OFF))[u] = 0u;
    __syncthreads();
    const bool single = (args.ph_lo == 0 && args.ph_hi == N_PHASES);
    XcdBarrier bar; bar.bar = (unsigned*)(ws + WS_CTL) + CW_BAR; bar.x = 0; bar.st = nullptr;
    if (single) bar = xcd_barrier_post((unsigned*)(ws + WS_CTL) + CW_BAR, MISC + 8);
    const int lo = args.ph_lo, hi = args.ph_hi;
#define IN(k) (lo <= (k) && (k) < hi)
#define SEAM(k) do { if (IN(k) && IN((k) + 1)) xcd_barrier(bar); } while (0)
    const int gw = F.vcu * NWAVES + F.wave, NGW = F.G * NWAVES;

    if (IN(0)) { p0_prologue(F); SEAM(0); }
    if (IN(1)) {
        pg8::Gemm g{F.XN, F.WIN, MPAD, NIN, DM, DM, DM}; pg8::StaticOrder S; S.init(MPAD, NIN, F.G, (int)blockIdx.x);
        EpiZ E{F.Z, F.out};
        pg8::gemm_phase<true>(F.lds, g, S, E);
        SEAM(1);
    }
    if (IN(2)) {
        for (int it = (int)blockIdx.x; it < 512; it += F.G) ret_simple_task(F, it >> 2, it & 3, true);
        __syncthreads();
        {
            LAS float* qs = (LAS float*)(F.lds + F.wave * 2048); LAS float* ps = qs + 128;
            for (int it = F.wave * F.G + (int)blockIdx.x; it < MS * 4; it += NWAVES * F.G) attn_simple_task(F, MP + (it >> 2), it & 3, qs, ps);
        }
        __syncthreads();
        attn_mfma_phase(F, (int)blockIdx.x, F.G);
        for (int it = (int)blockIdx.x; it < 512; it += F.G) ret_stepA(F, it >> 6, (it >> 4) & 3, it & 15);
        SEAM(2);
    }
    if (IN(3)) {
        for (int it = (int)blockIdx.x; it < 256; it += F.G) { const int bh = it >> 3, k = it & 7;
#pragma unroll 1
            for (int z = 0; z < 2; ++z) ret_stepB(F, bh >> 2, bh & 3, z ? 15 - k : k); }
        ret_final_state(F);
        for (int r = gw; r < MP; r += NGW) attn_combine_row(F, r);
        for (int it = gw; it < MS * 4; it += NGW) gn_gate_task(F, MP + (it >> 2), it & 3);
        SEAM(3);
    }
    if (IN(4)) {
        pg8::Gemm g{F.ABR, F.WBR, MPAD, DM, 512, KBR, KBR}; pg8::StaticOrder S; S.init(MPAD, DM, F.G, (int)blockIdx.x);
        EpiGateA E{F.Z, F.T1};
        pg8::gemm_phase<true>(F.lds, g, S, E);
        SEAM(4);
    }
    if (IN(5)) {
        pg8::Gemm g{F.ABR + 512, F.WBR + 512, MPAD, DM, DM, KBR, KBR}; pg8::StaticOrder S; S.init(MPAD, DM, F.G, (int)blockIdx.x);
        EpiGateR E{F.Z, F.T1, F.MB};
        pg8::gemm_phase<true>(F.lds, g, S, E);
        SEAM(5);
    }
    if (IN(6)) {
        pg8::Gemm g{F.MB, F.WOUT, MPAD, DM, DM, DM, DM}; pg8::StaticOrder S; S.init(MPAD, DM, F.G, (int)blockIdx.x);
        EpiF32 E{F.O, DM};
        pg8::gemm_phase<true>(F.lds, g, S, E);
        SEAM(6);
    }
    if (IN(7)) {
        for (int m = gw; m < MPAD; m += NGW) {
            if (m < MREAL) mix_norm_row(F, m);
            else { v4u z = {0u, 0u, 0u, 0u}; v4u* o = (v4u*)(F.XN2 + (size_t)m * DM) + F.lane; o[0] = z; o[64] = z; }
        }
        SEAM(7);
    }
    if (IN(8)) {
        pg8::Gemm g{F.XN2, F.WUP, MPAD, FF, DM, DM, DM}; pg8::StaticOrder S; S.init(MPAD, FF, F.G, (int)blockIdx.x);
        EpiRelu2 E{F.U, FF};
        pg8::gemm_phase<true>(F.lds, g, S, E);
        SEAM(8);
    }
    if (IN(9)) {
        pg8::Gemm g{F.U, F.WDN, MPAD, DM, FF, FF, FF}; pg8::StaticOrder S; S.init(MPAD, DM, F.G, (int)blockIdx.x);
        EpiF32 E{F.DN, DM};
        pg8::gemm_phase<true>(F.lds, g, S, E);
        SEAM(9);
    }
    if (IN(10)) {
        for (int m = gw; m < MREAL; m += NGW) mlp_norm_row(F, m);
    }
#undef IN
#undef SEAM
}

#ifndef MK_PER_PHASE
#define MK_PER_PHASE 0
#endif
extern "C" void kernel_launch(void* const* d_in, const int* in_sizes, int n_in, void* d_out, int out_size, void* d_ws, size_t ws_size, hipStream_t stream) {
    static int grid = 0;
    if (grid == 0) {
        if (n_in != 17 || out_size != (int)O_END || ws_size < WS_END) { fprintf(stderr, "kernel_launch: unexpected shapes (n_in %d out %d ws %zu)\n", n_in, out_size, ws_size); grid = -1; return; }
        int dev = 0, cus = 0, per_cu = 0;
        if (hipGetDevice(&dev) != hipSuccess || hipDeviceGetAttribute(&cus, hipDeviceAttributeMultiprocessorCount, dev) != hipSuccess) { grid = -1; return; }
        if (hipFuncSetAttribute((const void*)fwd_kernel, hipFuncAttributeMaxDynamicSharedMemorySize, LDS_BYTES) != hipSuccess) { fprintf(stderr, "kernel_launch: hipFuncSetAttribute failed\n"); grid = -1; return; }
        if (hipOccupancyMaxActiveBlocksPerMultiprocessor(&per_cu, (const void*)fwd_kernel, NWAVES * 64, LDS_BYTES) != hipSuccess || per_cu < 1) { fprintf(stderr, "kernel_launch: occupancy query says %d\n", per_cu); }
        (void)hipGetLastError();
        grid = cus;
    }
    if (grid < 0) return;
    (void)hipMemsetAsync((char*)d_ws + WS_CTL, 0, CTL_ZERO_BYTES, stream);
    Args a{};
    for (int i = 0; i < 17; ++i) a.in[i] = (const float*)d_in[i];
    a.out = (float*)d_out; a.ws = (unsigned char*)d_ws;
#if MK_PER_PHASE
    for (int p = 0; p < N_PHASES; ++p) { a.ph_lo = p; a.ph_hi = p + 1; hipLaunchKernelGGL(fwd_kernel, dim3(grid), dim3(NWAVES * 64), LDS_BYTES, stream, a); }
#else
    a.ph_lo = 0; a.ph_hi = N_PHASES;
    hipLaunchKernelGGL(fwd_kernel, dim3(grid), dim3(NWAVES * 64), LDS_BYTES, stream, a);
#endif
}
```
